# Optimizing an MI355X kernel written in HIP

```python
import math
import jax
import jax.numpy as jnp
from jax import lax
import numpy as np

D_MODEL = 1024
BATCH = 16
SEQ = 2048
DEPTH = 4

CHUNK = 64
Q_BLOCK = 128
ROPE_THETA = 10000.0
NORM_EPS = 1e-6

A_HEADS = 4
A_QK_DIM = 64
A_V_DIM = 2 * A_QK_DIM
B_HEADS = 8
B_Q_RANK = 256
B_KV_RANK = 128
B_NOPE_DIM = 64
B_ROPE_DIM = 32
B_V_DIM = 64
C_HEADS = 16
C_HEAD_DIM = 64
C_WIDTH = C_HEADS * C_HEAD_DIM

A_Q_COLS = A_HEADS * 2 * A_QK_DIM
A_V_COLS = A_HEADS * A_V_DIM
AB_IN_SPLITS = (A_Q_COLS, A_Q_COLS, A_V_COLS, B_Q_RANK, B_KV_RANK, B_ROPE_DIM)
AB_IN_DIM = sum(AB_IN_SPLITS)
AB_OUT_DIM = A_HEADS * A_V_DIM + B_HEADS * B_V_DIM

D_FF = ((8 * D_MODEL // 3 + 255) // 256) * 256
N_EVEN = (DEPTH + 1) // 2
N_ODD = DEPTH // 2

kernel_name = "hybrid_diff_mla_stickbreak_trunk"


def lambda_init(layer_idx):
    return 0.8 - 0.6 * math.exp(-0.3 * layer_idx)


def rms_norm(x, gain):
    xf = x.astype(jnp.float32)
    y = xf * lax.rsqrt(jnp.mean(xf * xf, axis=-1, keepdims=True) + NORM_EPS)
    return (y * gain.astype(jnp.float32)).astype(x.dtype)


def rope(x, pos):
    d = x.shape[-1]
    half = d // 2
    inv_freq = jnp.power(ROPE_THETA, -jnp.arange(half, dtype=jnp.float32) / half)
    ang = pos.astype(jnp.float32)[:, None] * inv_freq[None, :]
    bshape = (1, x.shape[1]) + (1,) * (x.ndim - 3) + (half,)
    cos = jnp.cos(ang).reshape(bshape)
    sin = jnp.sin(ang).reshape(bshape)
    xf = x.astype(jnp.float32)
    x1, x2 = xf[..., :half], xf[..., half:]
    return jnp.concatenate([x1 * cos - x2 * sin, x2 * cos + x1 * sin], axis=-1).astype(x.dtype)


def split_cols(x, sizes):
    idx = [int(i) for i in np.cumsum(sizes)[:-1]]
    return jnp.split(x, idx, axis=-1)


def sweep_query_blocks(block_fn, seq):
    return jnp.concatenate([block_fn(lo, lo + Q_BLOCK) for lo in range(0, seq, Q_BLOCK)], axis=1)


def chunk_causal_mask(lo, hi):
    q_chunk = jnp.arange(lo, hi) // CHUNK
    k_chunk = jnp.arange(hi) // CHUNK
    return k_chunk[None, :] <= q_chunk[:, None]


def masked_softmax(scores, mask):
    return jax.nn.softmax(jnp.where(mask, scores, -jnp.inf), axis=-1)


def differential_attention(q1, q2, k1, k2, v, lam, scale):
    def block(lo, hi):
        mask = chunk_causal_mask(lo, hi)
        s1 = jnp.einsum('bqhd,bkhd->bhqk', q1[:, lo:hi], k1[:, :hi]).astype(jnp.float32) * scale
        s2 = jnp.einsum('bqhd,bkhd->bhqk', q2[:, lo:hi], k2[:, :hi]).astype(jnp.float32) * scale
        p = masked_softmax(s1, mask) - lam * masked_softmax(s2, mask)
        return jnp.einsum('bhqk,bkhd->bqhd', p.astype(v.dtype), v[:, :hi])
    return sweep_query_blocks(block, q1.shape[1])


def latent_attention(q_nope, q_rope, k_nope, k_rope, v, scale):
    def block(lo, hi):
        mask = chunk_causal_mask(lo, hi)
        s = (jnp.einsum('bqhd,bkhd->bhqk', q_nope[:, lo:hi], k_nope[:, :hi])
             + jnp.einsum('bqhr,bkr->bhqk', q_rope[:, lo:hi], k_rope[:, :hi])).astype(jnp.float32) * scale
        p = masked_softmax(s, mask)
        return jnp.einsum('bhqk,bkhd->bqhd', p.astype(v.dtype), v[:, :hi])
    return sweep_query_blocks(block, q_nope.shape[1])


def stick_breaking_attention(q, k, v, scale):
    def block(lo, hi):
        q_pos = jnp.arange(lo, hi)
        k_pos = jnp.arange(hi)
        mask = k_pos[None, :] < q_pos[:, None]
        z = jnp.einsum('bqhd,bkhd->bhqk', q[:, lo:hi], k[:, :hi]).astype(jnp.float32) * scale
        sp = jnp.where(mask, jax.nn.softplus(z), 0.0)
        tail = lax.cumsum(sp, axis=3, reverse=True) - sp
        w = jnp.where(mask, jnp.exp(jax.nn.log_sigmoid(z) - tail), 0.0)
        return jnp.einsum('bhqk,bkhd->bqhd', w.astype(v.dtype), v[:, :hi])
    return sweep_query_blocks(block, q.shape[1])


def diff_mla_mixer(h, pos, layer_idx, w_in, a_q_norm, a_k_norm, a_lambda, a_out_norm,
                   b_q_a_norm, b_w_q_b, b_kv_a_norm, b_w_kv_b,
                   b_q_nope_norm, b_q_rope_norm, b_k_nope_norm, b_k_rope_norm, w_out):
    B, S, _ = h.shape
    a_q, a_k, a_v, b_ql, b_kvl, b_kr = split_cols(h @ w_in, AB_IN_SPLITS)

    a_q = rope(rms_norm(a_q.reshape(B, S, 2 * A_HEADS, A_QK_DIM), a_q_norm), pos)
    a_k = rope(rms_norm(a_k.reshape(B, S, 2 * A_HEADS, A_QK_DIM), a_k_norm), pos)
    a_q = a_q.reshape(B, S, A_HEADS, 2, A_QK_DIM)
    a_k = a_k.reshape(B, S, A_HEADS, 2, A_QK_DIM)
    a_v = a_v.reshape(B, S, A_HEADS, A_V_DIM)
    lam_f = a_lambda.astype(jnp.float32)
    lam_0 = lambda_init(layer_idx)
    lam = jnp.exp(jnp.sum(lam_f[0] * lam_f[1])) - jnp.exp(jnp.sum(lam_f[2] * lam_f[3])) + lam_0
    out_a = differential_attention(a_q[:, :, :, 0], a_q[:, :, :, 1], a_k[:, :, :, 0], a_k[:, :, :, 1],
                                   a_v, lam, A_QK_DIM ** -0.5)
    out_a = rms_norm(out_a, a_out_norm) * (1.0 - lam_0)

    q_b = (rms_norm(b_ql, b_q_a_norm) @ b_w_q_b).reshape(B, S, B_HEADS, B_NOPE_DIM + B_ROPE_DIM)
    kv_b = (rms_norm(b_kvl, b_kv_a_norm) @ b_w_kv_b).reshape(B, S, B_HEADS, B_NOPE_DIM + B_V_DIM)
    q_nope, q_rope = q_b[..., :B_NOPE_DIM], q_b[..., B_NOPE_DIM:]
    k_nope, b_v = kv_b[..., :B_NOPE_DIM], kv_b[..., B_NOPE_DIM:]
    q_nope = rms_norm(q_nope, b_q_nope_norm)
    k_nope = rms_norm(k_nope, b_k_nope_norm)
    q_rope = rope(rms_norm(q_rope, b_q_rope_norm), pos)
    k_rope = rope(rms_norm(b_kr, b_k_rope_norm), pos)
    out_b = latent_attention(q_nope, q_rope, k_nope, k_rope, b_v,
                             (B_NOPE_DIM + B_ROPE_DIM) ** -0.5)

    mixed = jnp.concatenate([out_a.reshape(B, S, A_HEADS * A_V_DIM),
                             out_b.reshape(B, S, B_HEADS * B_V_DIM)], axis=-1)
    return mixed @ w_out


def stick_breaking_mixer(h, w_in, w_out):
    B, S, _ = h.shape
    q, k, v = jnp.split(h @ w_in, 3, axis=-1)
    q = q.reshape(B, S, C_HEADS, C_HEAD_DIM)
    k = k.reshape(B, S, C_HEADS, C_HEAD_DIM)
    v = v.reshape(B, S, C_HEADS, C_HEAD_DIM)
    out = stick_breaking_attention(q, k, v, C_HEAD_DIM ** -0.5)
    return out.reshape(B, S, C_WIDTH) @ w_out


def swiglu(h, w_gate, w_up, w_down):
    return (jax.nn.silu(h @ w_gate) * (h @ w_up)) @ w_down


def setup_inputs(seed: int = 0) -> dict:
    key = jax.random.key(seed)
    keys = list(jax.random.split(key, 32))

    def dense(shape, fan_in):
        return jax.random.normal(keys.pop(), shape, jnp.float32) * fan_in ** -0.5

    def gain(shape):
        return 1.0 + 0.02 * jax.random.normal(keys.pop(), shape, jnp.float32)

    return {
        "x": jax.random.normal(keys.pop(), (BATCH, SEQ, D_MODEL), jnp.float32),
        "norm_mix": gain((DEPTH, D_MODEL)),
        "norm_ffn": gain((DEPTH, D_MODEL)),
        "ab_w_in": dense((N_EVEN, D_MODEL, AB_IN_DIM), D_MODEL),
        "a_q_norm": gain((N_EVEN, A_QK_DIM)),
        "a_k_norm": gain((N_EVEN, A_QK_DIM)),
        "a_lambda": 0.1 * jax.random.normal(keys.pop(), (N_EVEN, 4, A_QK_DIM), jnp.float32),
        "a_out_norm": gain((N_EVEN, A_V_DIM)),
        "b_q_a_norm": gain((N_EVEN, B_Q_RANK)),
        "b_w_q_b": dense((N_EVEN, B_Q_RANK, B_HEADS * (B_NOPE_DIM + B_ROPE_DIM)), B_Q_RANK),
        "b_kv_a_norm": gain((N_EVEN, B_KV_RANK)),
        "b_w_kv_b": dense((N_EVEN, B_KV_RANK, B_HEADS * (B_NOPE_DIM + B_V_DIM)), B_KV_RANK),
        "b_q_nope_norm": gain((N_EVEN, B_NOPE_DIM)),
        "b_q_rope_norm": gain((N_EVEN, B_ROPE_DIM)),
        "b_k_nope_norm": gain((N_EVEN, B_NOPE_DIM)),
        "b_k_rope_norm": gain((N_EVEN, B_ROPE_DIM)),
        "ab_w_out": dense((N_EVEN, AB_OUT_DIM, D_MODEL), AB_OUT_DIM),
        "c_w_in": dense((N_ODD, D_MODEL, 3 * C_WIDTH), D_MODEL),
        "c_w_out": dense((N_ODD, C_WIDTH, D_MODEL), C_WIDTH),
        "ffn_w_gate": dense((DEPTH, D_MODEL, D_FF), D_MODEL),
        "ffn_w_up": dense((DEPTH, D_MODEL, D_FF), D_MODEL),
        "ffn_w_down": dense((DEPTH, D_FF, D_MODEL), D_FF),
    }


def reference(x, norm_mix, norm_ffn, ab_w_in, a_q_norm, a_k_norm, a_lambda, a_out_norm,
              b_q_a_norm, b_w_q_b, b_kv_a_norm, b_w_kv_b,
              b_q_nope_norm, b_q_rope_norm, b_k_nope_norm, b_k_rope_norm, ab_w_out,
              c_w_in, c_w_out, ffn_w_gate, ffn_w_up, ffn_w_down):
    pos = jnp.arange(x.shape[1], dtype=jnp.int32)
    for l in range(DEPTH):
        h = rms_norm(x, norm_mix[l])
        i = l // 2
        if l % 2 == 0:
            x = x + diff_mla_mixer(h, pos, l, ab_w_in[i], a_q_norm[i], a_k_norm[i], a_lambda[i],
                                   a_out_norm[i], b_q_a_norm[i], b_w_q_b[i], b_kv_a_norm[i],
                                   b_w_kv_b[i], b_q_nope_norm[i], b_q_rope_norm[i],
                                   b_k_nope_norm[i], b_k_rope_norm[i], ab_w_out[i])
        else:
            x = x + stick_breaking_mixer(h, c_w_in[i], c_w_out[i])
        h = rms_norm(x, norm_ffn[l])
        x = x + swiglu(h, ffn_w_gate[l], ffn_w_up[l], ffn_w_down[l])
    return x
```

```cpp
#include <hip/hip_runtime.h>
#include <hip/hip_cooperative_groups.h>
#include <cstdio>
#include <cstdint>
namespace cg = cooperative_groups;

#define LAS __attribute__((address_space(3)))
typedef unsigned short bf16_t;
typedef short bf16x8 __attribute__((ext_vector_type(8)));
typedef short s16x4 __attribute__((ext_vector_type(4)));
typedef float f32x4 __attribute__((ext_vector_type(4)));
typedef float f32x16 __attribute__((ext_vector_type(16)));
typedef unsigned u32x4 __attribute__((ext_vector_type(4)));
typedef unsigned u32x2 __attribute__((ext_vector_type(2)));
typedef float f32x2_t __attribute__((ext_vector_type(2)));
typedef __bf16 bf16x2_t __attribute__((ext_vector_type(2)));

__device__ __forceinline__ unsigned pk2(float lo, float hi) { f32x2_t v = {lo, hi}; bf16x2_t b = __builtin_convertvector(v, bf16x2_t); return __builtin_bit_cast(unsigned, b); }
__device__ __forceinline__ float bflo(unsigned w) { return __uint_as_float(w << 16); }
__device__ __forceinline__ float bfhi(unsigned w) { return __uint_as_float(w & 0xffff0000u); }
__device__ __forceinline__ int launder_tid_(int wv_s) { int ln; asm volatile("v_mbcnt_lo_u32_b32 %0, -1, 0\n\tv_mbcnt_hi_u32_b32 %0, -1, %0" : "=v"(ln)); return wv_s * 64 + ln; }
#define launder_tid() launder_tid_(wv_s)

#define SWZ_XOR(v, m) __int_as_float(__builtin_amdgcn_ds_swizzle(__float_as_int(v), (((m) << 10) | 0x1f)))
__device__ __forceinline__ float x32_sum(float v) { auto r = __builtin_amdgcn_permlane32_swap(__float_as_uint(v), __float_as_uint(v), false, false); return __uint_as_float(r[0]) + __uint_as_float(r[1]); }
__device__ __forceinline__ float x32_max(float v) { auto r = __builtin_amdgcn_permlane32_swap(__float_as_uint(v), __float_as_uint(v), false, false); return fmaxf(__uint_as_float(r[0]), __uint_as_float(r[1])); }
__device__ __forceinline__ float uni(float v) { return __uint_as_float(__builtin_amdgcn_readfirstlane(__float_as_uint(v))); }
__device__ __forceinline__ float ex2(float x) { return __builtin_amdgcn_exp2f(x); }
__device__ __forceinline__ float lg2(float x) { return __builtin_amdgcn_logf(x); }

namespace pg8 {
constexpr int BM = 256, BK = 64, HALF = 128, HTB = HALF * BK * 2, STAGE_BYTES = 8 * HTB, NXCD = 8, WGM = 4;
__host__ __device__ __forceinline__ int lds_byte(int r, int c) { const int st = (r >> 4) * 2 + (c >> 5), rr = r & 15, cc = c & 31, ob = rr * 64 + cc * 2; return st * 1024 + (ob ^ (((ob >> 9) & 1) << 5)); }
__host__ __device__ __forceinline__ void stage_rc(int b, int& R, int& C) { const int st = b / 1024, sb = b % 1024, swz = sb ^ (((sb >> 9) & 1) << 5); R = (st >> 1) * 16 + swz / 64; C = (st & 1) * 32 + (swz % 64) / 2; }
__host__ __device__ __forceinline__ int perm32(int rho) { const int n = rho >> 4, i = rho & 15; return 8 * (i >> 2) + 4 * n + (i & 3); }

struct Unit { int pm, pn; };

struct StaticOrder {
    int nM, nN, nwg, G, c;
    __device__ void init(int M, int N, int G_, int c_) { nM = M / BM; nN = N / BM; nwg = nM * nN; G = G_; c = c_; }
    __device__ bool next(int i, Unit& u) const {
        const long L = (long)i * G + c; if (L >= nwg) return false;
        int wgid = (int)L; { const int q = nwg / NXCD, r = nwg % NXCD, xcd = wgid % NXCD, off = wgid / NXCD; wgid = (xcd < r ? xcd * (q + 1) : r * (q + 1) + (xcd - r) * q) + off; }
        const int nig = WGM * nN, gid = wgid / nig, fm = gid * WGM, gsz = (nM - fm) < WGM ? (nM - fm) : WGM;
        u.pm = fm + ((wgid % nig) % gsz); u.pn = (wgid % nig) / gsz; return true;
    }
};

__device__ __forceinline__ float rstd_row4(const float* ss, int row, int fq) {
    const f32x4 a = *(const f32x4*)(ss + (size_t)row * 16 + fq * 4);
    float t = (a.x + a.y) + (a.z + a.w);
    t += SWZ_XOR(t, 16); t = x32_sum(t);
    return rsqrtf(t * (1.f / 1024.f) + 1e-6f);
}
__device__ __forceinline__ float rstd_row16(const float* ss, int row) {
    const f32x4* p = (const f32x4*)(ss + (size_t)row * 16); const f32x4 a = p[0], b = p[1], c = p[2], d = p[3];
    const float t = (((a.x + a.y) + (a.z + a.w)) + ((b.x + b.y) + (b.z + b.w))) + (((c.x + c.y) + (c.z + c.w)) + ((d.x + d.y) + (d.z + d.w)));
    return rsqrtf(t * (1.f / 1024.f) + 1e-6f);
}
struct EpiStore {
    static constexpr bool PERM = true;
    bf16_t* O; int ldc; float scale; int nsc; const float* ss; int mode;
    __device__ __forceinline__ void operator()(const f32x4 (&acc)[2][2][4][2], const Unit& u, int wr, int wc, int fr, int fq) const {
        const int row0 = u.pm * BM + wr * 64 + fr, col0 = u.pn * BM + wc * 32 + 8 * fq;
        const float sc = (u.pn < nsc) ? scale : 1.f;
        if (mode == 2) {
            const float mine = rstd_row16(ss, col0 + (fr >> 3) * HALF + (fr & 7)) * sc;
            float cs[2][8];
#pragma unroll
            for (int bj = 0; bj < 2; ++bj)
#pragma unroll
                for (int e = 0; e < 8; ++e) cs[bj][e] = __int_as_float(__builtin_amdgcn_ds_bpermute((fq * 16 + bj * 8 + e) << 2, __float_as_int(mine)));
#pragma unroll
            for (int ai = 0; ai < 2; ++ai)
#pragma unroll
                for (int m = 0; m < 4; ++m) { bf16_t* rowp = O + (size_t)(row0 + ai * HALF + m * 16) * ldc + col0;
#pragma unroll
                    for (int bj = 0; bj < 2; ++bj) { const f32x4 v0 = acc[ai][bj][m][0], v1 = acc[ai][bj][m][1];
                        u32x4 w; w.x = pk2(v0[0] * cs[bj][0], v0[1] * cs[bj][1]); w.y = pk2(v0[2] * cs[bj][2], v0[3] * cs[bj][3]); w.z = pk2(v1[0] * cs[bj][4], v1[1] * cs[bj][5]); w.w = pk2(v1[2] * cs[bj][6], v1[3] * cs[bj][7]);
                        *(u32x4*)(rowp + bj * HALF) = w; } }
        } else {
            float rsv[2][4];
#pragma unroll
            for (int ai = 0; ai < 2; ++ai)
#pragma unroll
                for (int m = 0; m < 4; ++m) { rsv[ai][m] = sc; if (mode == 1) rsv[ai][m] *= rstd_row4(ss, row0 + ai * HALF + m * 16, fq); }
#pragma unroll
            for (int ai = 0; ai < 2; ++ai)
#pragma unroll
                for (int m = 0; m < 4; ++m) { const int row = row0 + ai * HALF + m * 16; bf16_t* rowp = O + (size_t)row * ldc + col0;
                    const float rs = rsv[ai][m];
#pragma unroll
                    for (int bj = 0; bj < 2; ++bj) { const f32x4 v0 = acc[ai][bj][m][0] * rs, v1 = acc[ai][bj][m][1] * rs;
                        u32x4 w; w.x = pk2(v0[0], v0[1]); w.y = pk2(v0[2], v0[3]); w.z = pk2(v1[0], v1[1]); w.w = pk2(v1[2], v1[3]);
                        *(u32x4*)(rowp + bj * HALF) = w; } }
        }
    }
};

struct EpiLatent {
    static constexpr bool PERM = true;
    bf16_t* O; const float* gqn; const float* gqr; const float* gkn; const float2* tab32; float qscale; int pn_off;
    __device__ __forceinline__ void operator()(const f32x4 (&acc)[2][2][4][2], const Unit& u, int wr, int wc, int fr, int fq) const {
        const int row0 = u.pm * BM + wr * 64 + fr; const int tp = u.pn + pn_off;
        if (tp != 2) {
            const float* g = (tp < 2) ? gqn : gkn; const float sc = (tp < 2) ? qscale : 1.f;
            f32x4 gv[2][2];
#pragma unroll
            for (int bj = 0; bj < 2; ++bj)
#pragma unroll
                for (int n = 0; n < 2; ++n) gv[bj][n] = *(const f32x4*)(g + 32 * bj + 8 * fq + 4 * n) * sc;
#pragma unroll
            for (int ai = 0; ai < 2; ++ai)
#pragma unroll
                for (int m = 0; m < 4; ++m) { bf16_t* rowp = O + (size_t)(row0 + ai * HALF + m * 16) * 1280 + ((tp < 2) ? 96 * (4 * tp + wc) : 768 + 64 * (4 * (tp - 3) + wc)) + 8 * fq;
                    float ss = 0.f;
#pragma unroll
                    for (int bj = 0; bj < 2; ++bj)
#pragma unroll
                        for (int n = 0; n < 2; ++n) { const f32x4 v = acc[ai][bj][m][n]; ss += (v[0] * v[0] + v[1] * v[1]) + (v[2] * v[2] + v[3] * v[3]); }
                    ss += SWZ_XOR(ss, 16); ss = x32_sum(ss);
                    const float rstd = rsqrtf(ss * (1.f / 64.f) + 1e-6f);
#pragma unroll
                    for (int bj = 0; bj < 2; ++bj) { const f32x4 v0 = acc[ai][bj][m][0] * rstd * gv[bj][0], v1 = acc[ai][bj][m][1] * rstd * gv[bj][1];
                        u32x4 w; w.x = pk2(v0[0], v0[1]); w.y = pk2(v0[2], v0[3]); w.z = pk2(v1[0], v1[1]); w.w = pk2(v1[2], v1[3]);
                        *(u32x4*)(rowp + bj * 32) = w; } }
        } else {
            const int ib = 8 * (fq & 1); const bool up = (fq >= 2);
            f32x4 gv[2];
#pragma unroll
            for (int n = 0; n < 2; ++n) gv[n] = *(const f32x4*)(gqr + 8 * fq + 4 * n);
#pragma unroll
            for (int ai = 0; ai < 2; ++ai)
#pragma unroll
                for (int m = 0; m < 4; ++m) { const int row = row0 + ai * HALF + m * 16; bf16_t* rowp = O + (size_t)row * 1280 + 96 * wc + 64 + 8 * fq;
                    const f32x4* tp = (const f32x4*)(tab32 + (size_t)(row & (2048 - 1)) * 16 + ib);
                    const f32x4 t0 = tp[0], t1 = tp[1], t2 = tp[2], t3 = tp[3];
                    const float cs[8] = {t0.x, t0.z, t1.x, t1.z, t2.x, t2.z, t3.x, t3.z}, sn[8] = {t0.y, t0.w, t1.y, t1.w, t2.y, t2.w, t3.y, t3.w};
#pragma unroll
                    for (int bj = 0; bj < 2; ++bj) {
                        const f32x4 a0 = acc[ai][bj][m][0], a1 = acc[ai][bj][m][1];
                        float ss = (a0[0] * a0[0] + a0[1] * a0[1]) + (a0[2] * a0[2] + a0[3] * a0[3]) + (a1[0] * a1[0] + a1[1] * a1[1]) + (a1[2] * a1[2] + a1[3] * a1[3]);
                        ss += SWZ_XOR(ss, 16); ss = x32_sum(ss);
                        const float rstd = rsqrtf(ss * (1.f / 32.f) + 1e-6f) * qscale;
                        float y[8], o[8];
#pragma unroll
                        for (int e = 0; e < 4; ++e) { y[e] = a0[e] * rstd * gv[0][e]; y[4 + e] = a1[e] * rstd * gv[1][e]; }
#pragma unroll
                        for (int e = 0; e < 8; ++e) { auto r = __builtin_amdgcn_permlane32_swap(__float_as_uint(y[e]), __float_as_uint(y[e]), false, false);
                            const float y1 = __uint_as_float(r[0]), y2 = __uint_as_float(r[1]);
                            o[e] = up ? (y2 * cs[e] + y1 * sn[e]) : (y1 * cs[e] - y2 * sn[e]); }
                        u32x4 w; w.x = pk2(o[0], o[1]); w.y = pk2(o[2], o[3]); w.z = pk2(o[4], o[5]); w.w = pk2(o[6], o[7]);
                        *(u32x4*)(rowp + bj * 384) = w; } }
        }
    }
};
__device__ __forceinline__ float silu_mul(float g, float u) { return g * __builtin_amdgcn_rcpf(1.f + ex2(-1.4426950408889634f * g)) * u; }
struct EpiSwiglu {
    static constexpr bool PERM = true;
    bf16_t* O; int ldc; const float* ss;
    __device__ __forceinline__ void operator()(const f32x4 (&acc)[2][2][4][2], const Unit& u, int wr, int wc, int fr, int fq) const {
        const int row0 = u.pm * BM + wr * 64 + fr, col0 = u.pn * HALF + wc * 32 + 8 * fq;
        float rsv[2][4];
#pragma unroll
        for (int ai = 0; ai < 2; ++ai)
#pragma unroll
            for (int m = 0; m < 4; ++m) rsv[ai][m] = rstd_row4(ss, row0 + ai * HALF + m * 16, fq);
#pragma unroll
        for (int ai = 0; ai < 2; ++ai)
#pragma unroll
            for (int m = 0; m < 4; ++m) { const int row = row0 + ai * HALF + m * 16; bf16_t* rowp = O + (size_t)row * ldc + col0; const float rs = rsv[ai][m];
                const f32x4 g0 = acc[ai][0][m][0] * rs, g1 = acc[ai][0][m][1] * rs, u0 = acc[ai][1][m][0] * rs, u1 = acc[ai][1][m][1] * rs;
                u32x4 w; w.x = pk2(silu_mul(g0[0], u0[0]), silu_mul(g0[1], u0[1])); w.y = pk2(silu_mul(g0[2], u0[2]), silu_mul(g0[3], u0[3]));
                w.z = pk2(silu_mul(g1[0], u1[0]), silu_mul(g1[1], u1[1])); w.w = pk2(silu_mul(g1[2], u1[2]), silu_mul(g1[3], u1[3]));
                *(u32x4*)rowp = w; }
    }
};
struct EpiResid {
    static constexpr bool PERM = false;
    float* out; int ldc; bf16_t* xb; float* ss;
    __device__ __forceinline__ void operator()(const f32x4 (&acc)[2][2][4][2], const Unit& u, int wr, int wc, int fr, int fq) const {
        const int row0 = u.pm * BM + wr * 64 + fr, col0 = u.pn * BM + wc * 32 + 4 * fq;
#pragma unroll
        for (int ai = 0; ai < 2; ++ai) {
            u32x2 bv[4][2][2];
#pragma unroll
            for (int m = 0; m < 4; ++m)
#pragma unroll
                for (int bj = 0; bj < 2; ++bj)
#pragma unroll
                    for (int n = 0; n < 2; ++n) bv[m][bj][n] = *(const u32x2*)(xb + (size_t)(row0 + ai * HALF + m * 16) * ldc + col0 + bj * HALF + n * 16);
            asm volatile("" ::: "memory");
#pragma unroll
            for (int m = 0; m < 4; ++m) { const int row = row0 + ai * HALF + m * 16; const size_t off = (size_t)row * ldc + col0; float sq = 0.f;
#pragma unroll
                for (int bj = 0; bj < 2; ++bj)
#pragma unroll
                    for (int n = 0; n < 2; ++n) { const size_t p = off + bj * HALF + n * 16; const u32x2 b = bv[m][bj][n];
                        f32x4 v = acc[ai][bj][m][n]; v[0] += bflo(b.x); v[1] += bfhi(b.x); v[2] += bflo(b.y); v[3] += bfhi(b.y);
                        if (out) { *(f32x4*)(out + p) = v; }
                        else { sq += (v[0] * v[0] + v[1] * v[1]) + (v[2] * v[2] + v[3] * v[3]);
                               u32x2 w; w.x = pk2(v[0], v[1]); w.y = pk2(v[2], v[3]); *(u32x2*)(xb + p) = w; } }
                if (!out) { sq += SWZ_XOR(sq, 16); sq = x32_sum(sq);
                            if (fq == 0) ss[(size_t)row * 16 + u.pn * 4 + wc] = sq; } }
            asm volatile("" ::: "memory");
        }
    }
};

template <class Epi, int K, int LDA, int LDB>
__device__ __forceinline__ void gemm_phase(LAS unsigned char* lds, const bf16_t* gA, const bf16_t* gBt, const StaticOrder& S, const Epi& E, int wv_s) {
    const int tid = launder_tid(), wid = __builtin_amdgcn_readfirstlane(tid >> 6), lane = tid & 63, wr = wid >> 2, wc = wid & 3, fr = lane & 15, fq = lane >> 4;
    int nt = K / BK; asm volatile("" : "+s"(nt));
    unsigned voffA[2], voffB[2];
#pragma unroll
    for (int i = 0; i < 2; ++i) { int R, C; stage_rc(tid * 16 + i * 8192, R, C); const int Rb = Epi::PERM ? ((R & ~31) + perm32(R & 31)) : R;
        voffA[i] = (unsigned)(R * LDA + C) * 2u; voffB[i] = (unsigned)(Rb * LDB + C) * 2u; }
    constexpr size_t kstep = (size_t)(BK * 2);
    constexpr size_t hsA = (size_t)HALF * LDA * 2, hsB = (size_t)HALF * LDB * 2;
    constexpr size_t tsA = 2 * hsA, tsB = 2 * hsB;
    const unsigned ldsw = (unsigned)wid * 1024u;
    const int aoff = lds_byte(wr * 64 + fr, fq * 8), boff = lds_byte(wc * 32 + fr, fq * 8);
#define PG8_SA(b, h) (((b) * 2 + (h)) * HTB)
#define PG8_SB(b, h) ((4 + (b) * 2 + (h)) * HTB)
#define PG8_STAGE(bufoff, gbase, voff) do { _Pragma("unroll") for (int _i = 0; _i < 2; ++_i) \
        __builtin_amdgcn_global_load_lds((const unsigned*)((const char*)(gbase) + (voff)[_i]), (LAS unsigned*)(lds + (bufoff) + ldsw + _i * 8192), 16, 0, 0); } while (0)
#define PG8_LDA(dst, b, h) do { _Pragma("unroll") for (int m = 0; m < 4; ++m) _Pragma("unroll") for (int k = 0; k < 2; ++k) dst[m][k] = *(const LAS bf16x8*)(lds + PG8_SA(b, h) + aoff + m * 2048 + k * 1024); } while (0)
#define PG8_LDB(dst, b, h) do { _Pragma("unroll") for (int n = 0; n < 2; ++n) _Pragma("unroll") for (int k = 0; k < 2; ++k) dst[n][k] = *(const LAS bf16x8*)(lds + PG8_SB(b, h) + boff + n * 2048 + k * 1024); } while (0)
#define PG8_MMA(ai, bj, At, Bt) do { __builtin_amdgcn_s_setprio(1); _Pragma("unroll") for (int m = 0; m < 4; ++m) _Pragma("unroll") for (int n = 0; n < 2; ++n) _Pragma("unroll") for (int k = 0; k < 2; ++k) \
        acc[ai][bj][m][n] = __builtin_amdgcn_mfma_f32_16x16x32_bf16(Bt[n][k], At[m][k], acc[ai][bj][m][n], 0, 0, 0); __builtin_amdgcn_s_setprio(0); } while (0)
#define PG8_WAIT_V(n) asm volatile("s_waitcnt vmcnt(" #n ")" ::: "memory")
#define PG8_WAIT_L(n) asm volatile("s_waitcnt lgkmcnt(" #n ")" ::: "memory")
#define PG8_BAR __builtin_amdgcn_s_barrier()
#define PG8_SCHED __builtin_amdgcn_sched_barrier(0)
    Unit cur, nxt; int ui = 0;
    if (!S.next(0, cur)) return;
    f32x4 acc[2][2][4][2];
#pragma unroll
    for (int a = 0; a < 2; ++a)
#pragma unroll
        for (int b = 0; b < 2; ++b)
#pragma unroll
            for (int m = 0; m < 4; ++m)
#pragma unroll
                for (int n = 0; n < 2; ++n) acc[a][b][m][n] = (f32x4){0.f, 0.f, 0.f, 0.f};
    bf16x8 At[4][2], B0[2][2], B1[2][2];
    const char* cA = (const char*)gA + (size_t)cur.pm * tsA; const char* cB = (const char*)gBt + (size_t)cur.pn * tsB;
    PG8_STAGE(PG8_SB(0, 0), cB, voffB); PG8_STAGE(PG8_SB(0, 1), cB + hsB, voffB); PG8_STAGE(PG8_SA(0, 0), cA, voffA); PG8_STAGE(PG8_SA(0, 1), cA + hsA, voffA);
    if (wr == 1) PG8_BAR;
    PG8_WAIT_V(2); PG8_BAR;
    PG8_STAGE(PG8_SB(1, 0), cB + kstep, voffB); PG8_STAGE(PG8_SA(1, 0), cA + kstep, voffA); PG8_STAGE(PG8_SB(1, 1), cB + hsB + kstep, voffB);
    PG8_WAIT_V(6); PG8_BAR;
    for (;;) {
        const bool has_next = S.next(ui + 1, nxt);
        const char* nA = has_next ? (const char*)gA + (size_t)nxt.pm * tsA : cA; const char* nB = has_next ? (const char*)gBt + (size_t)nxt.pn * tsB : cB;
#pragma nounroll
        for (int t = 0; t < nt; t += 2) {
            const bool last = (t == nt - 2);
            const char* a1 = cA + (size_t)(t + 1) * kstep;
            const char* a2 = last ? nA : cA + (size_t)(t + 2) * kstep; const char* b2 = last ? nB : cB + (size_t)(t + 2) * kstep;
            const char* a3 = a2 + kstep; const char* b3 = b2 + kstep;
            PG8_LDB(B0, 0, 0); PG8_LDB(B1, 0, 1); PG8_SCHED; PG8_LDA(At, 0, 0); PG8_STAGE(PG8_SA(1, 1), a1 + hsA, voffA);
            PG8_WAIT_V(8); PG8_WAIT_L(0); PG8_BAR; PG8_MMA(0, 0, At, B0); PG8_MMA(0, 1, At, B1); PG8_BAR; PG8_SCHED;
            PG8_LDA(At, 0, 1); PG8_STAGE(PG8_SB(0, 0), b2, voffB); PG8_STAGE(PG8_SB(0, 1), b2 + hsB, voffB); PG8_STAGE(PG8_SA(0, 0), a2, voffA);
            PG8_WAIT_V(8); PG8_WAIT_L(0); PG8_BAR; PG8_MMA(1, 0, At, B0); PG8_MMA(1, 1, At, B1); PG8_BAR; PG8_SCHED;
            PG8_LDB(B0, 1, 0); PG8_LDB(B1, 1, 1); PG8_SCHED; PG8_LDA(At, 1, 0); PG8_STAGE(PG8_SA(0, 1), a2 + hsA, voffA);
            PG8_WAIT_V(8); PG8_WAIT_L(0); PG8_BAR; PG8_MMA(0, 0, At, B0); PG8_MMA(0, 1, At, B1); PG8_BAR; PG8_SCHED;
            PG8_LDA(At, 1, 1); PG8_STAGE(PG8_SB(1, 0), b3, voffB); PG8_STAGE(PG8_SB(1, 1), b3 + hsB, voffB); PG8_STAGE(PG8_SA(1, 0), a3, voffA);
            PG8_WAIT_V(8); PG8_WAIT_L(0); PG8_BAR; PG8_MMA(1, 0, At, B0); PG8_MMA(1, 1, At, B1); PG8_BAR; PG8_SCHED;
        }
        if (wr == 0) PG8_BAR;
        E(acc, cur, wr, wc, fr, fq);
        if (!has_next) break;
#pragma unroll
        for (int a = 0; a < 2; ++a)
#pragma unroll
            for (int b = 0; b < 2; ++b)
#pragma unroll
                for (int m = 0; m < 4; ++m)
#pragma unroll
                    for (int n = 0; n < 2; ++n) acc[a][b][m][n] = (f32x4){0.f, 0.f, 0.f, 0.f};
        cur = nxt; cA = nA; cB = nB; ++ui;
        if (wr == 1) PG8_BAR;
    }
    PG8_WAIT_V(0);
    PG8_BAR;
#undef PG8_SA
#undef PG8_SB
#undef PG8_STAGE
#undef PG8_LDA
#undef PG8_LDB
#undef PG8_MMA
#undef PG8_WAIT_V
#undef PG8_WAIT_L
#undef PG8_BAR
#undef PG8_SCHED
}
}

constexpr int NB = 16, SEQ = 2048, DM = 1024, MT = NB * SEQ, DFF = 2816;
constexpr float EPS = 1e-6f;
constexpr float LOG2E = 1.4426950408889634f;
constexpr size_t MiB = 1u << 20;
constexpr size_t WS_EVEN = 0, EVEN_STRIDE = 8 * MiB;
constexpr size_t WS_ODD = 16 * MiB, ODD_STRIDE = 8 * MiB;
constexpr size_t WS_FFN = 32 * MiB, FFN_STRIDE = 17 * MiB;
constexpr size_t WS_ROPE = 100 * MiB;
constexpr size_t WS_XB = 102 * MiB, WS_MIX = 166 * MiB, WS_R = 230 * MiB;
constexpr size_t WS_P = WS_R, WS_VTA = WS_R + 96 * MiB, WS_QB = WS_R + 128 * MiB, WS_VTB = WS_R + 208 * MiB;
constexpr size_t WS_QK = WS_R, WS_VTC = WS_R + 128 * MiB, WS_ACT = WS_R, WS_CTL = 470 * MiB, CTL_BYTES = 16384, WS_SS = 471 * MiB, WS_END = 473 * MiB;
constexpr int LDS_BYTES = 131072 + 128;
#ifndef ATT_REP
#define ATT_REP 1
#endif
#ifndef ATT_REP_O
#define ATT_REP_O 1
#endif
#ifndef GU_REP
#define GU_REP 1
#endif
#ifndef EW_REP
#define EW_REP 1
#endif
#ifndef SYNC_REP
#define SYNC_REP 1
#endif

struct Args { const float* in[22]; float* out; unsigned char* ws; };
typedef const __attribute__((address_space(4))) Args* KA;
__device__ __forceinline__ KA ka_get() { KA p = (KA)__builtin_amdgcn_kernarg_segment_ptr(); asm volatile("" : "+s"(p)); return p; }

__device__ __forceinline__ float wave_sum(float v) {
    v += SWZ_XOR(v, 1); v += SWZ_XOR(v, 2); v += SWZ_XOR(v, 4); v += SWZ_XOR(v, 8); v += SWZ_XOR(v, 16);
    return x32_sum(v);
}

struct PJ { const float* W; int K, ld, c0, ncols, grp, sgrp, dgrp; bf16_t* WT; int row_off; const float* gain; int ldd, kofs, mode; };
__device__ __forceinline__ PJ get_job(int j, KA a) {
    PJ p; unsigned char* ws = a->ws;
    p.grp = 1 << 20; p.sgrp = 0; p.dgrp = 0; p.c0 = 0; p.row_off = 0; p.gain = nullptr; p.ldd = 0; p.kofs = 0; p.mode = 0;
    if (j < 16) {
        const int i = j / 8, s = j % 8; unsigned char* wb = ws + WS_EVEN + i * EVEN_STRIDE; const float* win = a->in[3] + (size_t)i * 1024 * 1952; const float* gm = a->in[1] + (size_t)(2 * i) * 1024;
        if (s == 0) { p.W = win; p.K = 1024; p.ld = 1952; p.c0 = 0; p.ncols = 1024; p.WT = (bf16_t*)wb; p.row_off = 0; p.gain = gm; }
        else if (s == 1) { p.W = win; p.K = 1024; p.ld = 1952; p.c0 = 1024; p.ncols = 512; p.WT = (bf16_t*)(wb + 3 * MiB); p.gain = gm; }
        else if (s == 2) { p.W = win; p.K = 1024; p.ld = 1952; p.c0 = 1536; p.ncols = 416; p.WT = (bf16_t*)wb; p.row_off = 1024; p.gain = gm; }
        else if (s == 3) { p.W = a->in[9] + (size_t)i * 256 * 768; p.K = 256; p.ld = 768; p.ncols = 512; p.WT = (bf16_t*)(wb + 6 * MiB); p.ldd = 384; p.mode = 1; }
        else if (s == 7) { p.W = a->in[9] + (size_t)i * 256 * 768; p.K = 256; p.ld = 768; p.ncols = 256; p.WT = (bf16_t*)(wb + 6 * MiB); p.ldd = 384; p.mode = 2; }
        else if (s == 4) { p.W = a->in[11] + (size_t)i * 128 * 1024; p.K = 128; p.ld = 1024; p.c0 = 0; p.ncols = 512; p.WT = (bf16_t*)(wb + 6 * MiB); p.ldd = 384; p.kofs = 256; p.mode = 3; }
        else if (s == 5) { p.W = a->in[11] + (size_t)i * 128 * 1024; p.K = 128; p.ld = 1024; p.c0 = 64; p.ncols = 512; p.grp = 64; p.sgrp = 128; p.dgrp = 64; p.WT = (bf16_t*)(wb + 6 * MiB + 960 * 1024); p.ldd = 384; p.kofs = 256; }
        else { p.W = a->in[16] + (size_t)i * 1024 * 1024; p.K = 1024; p.ld = 1024; p.ncols = 1024; p.WT = (bf16_t*)(wb + 4 * MiB); }
    } else if (j < 22) {
        const int i = (j - 16) / 3, s = (j - 16) % 3; unsigned char* wb = ws + WS_ODD + i * ODD_STRIDE; const float* gm = a->in[1] + (size_t)(2 * i + 1) * 1024;
        if (s == 0) { p.W = a->in[17] + (size_t)i * 1024 * 3072; p.K = 1024; p.ld = 3072; p.c0 = 0; p.ncols = 2048; p.WT = (bf16_t*)wb; p.gain = gm; }
        else if (s == 1) { p.W = a->in[17] + (size_t)i * 1024 * 3072; p.K = 1024; p.ld = 3072; p.c0 = 2048; p.ncols = 1024; p.WT = (bf16_t*)(wb + 4 * MiB); p.gain = gm; }
        else { p.W = a->in[18] + (size_t)i * 1024 * 1024; p.K = 1024; p.ld = 1024; p.ncols = 1024; p.WT = (bf16_t*)(wb + 6 * MiB); }
    } else {
        const int l = (j - 22) / 3, s = (j - 22) % 3; unsigned char* wb = ws + WS_FFN + l * FFN_STRIDE; const float* gf = a->in[2] + (size_t)l * 1024;
        if (s == 0) { p.W = a->in[19] + (size_t)l * 1024 * DFF; p.K = 1024; p.ld = DFF; p.ncols = DFF; p.grp = 128; p.sgrp = 128; p.dgrp = 256; p.WT = (bf16_t*)wb; p.row_off = 0; p.gain = gf; }
        else if (s == 1) { p.W = a->in[20] + (size_t)l * 1024 * DFF; p.K = 1024; p.ld = DFF; p.ncols = DFF; p.grp = 128; p.sgrp = 128; p.dgrp = 256; p.WT = (bf16_t*)wb; p.row_off = 128; p.gain = gf; }
        else { p.W = a->in[21] + (size_t)l * DFF * 1024; p.K = DFF; p.ld = 1024; p.ncols = 1024; p.WT = (bf16_t*)(wb + 11 * MiB); }
    }
    return p;
}
constexpr int NJOBS = 34;

__device__ __forceinline__ void prep_phase(KA a, LAS unsigned char* lds, int NGW, int wv_s) {
    const int tid = launder_tid(), lane = tid & 63, wave = __builtin_amdgcn_readfirstlane(tid >> 6), gw = blockIdx.x * 8 + wave;
    LAS float* scr = (LAS float*)(lds + wave * 8448);
    int rot = 0;
    for (int j = 0; j < NJOBS; ++j) {
        PJ p = get_job(j, a); if (p.ldd == 0) p.ldd = p.K;
        const int nblk = p.ncols / 32, nitems = (p.K / 64) * nblk;
        int start = gw - rot; if (start < 0) start += NGW;
        for (int it = start; it < nitems; it += NGW) {
            const int kb = it / nblk, nb = it % nblk, k0 = 64 * kb, nn0 = 32 * nb;
            const int q = nn0 / p.grp, r = nn0 % p.grp;
            int sc = p.c0 + q * p.sgrp + r, dr = p.row_off + q * p.dgrp + r;
            if (p.mode == 1) { const int hh = nb >> 1, hf = nb & 1; sc = 96 * hh + 32 * hf; dr = 256 * (hh >> 2) + 128 * hf + 32 * (hh & 3); }
            else if (p.mode == 2) { sc = 96 * nb + 64; dr = 512 + 128 * (nb >> 2) + 32 * (nb & 3); }
            else if (p.mode == 3) { const int hh = nb >> 1, hf = nb & 1; sc = 128 * hh + 32 * hf; dr = 768 + 256 * (hh >> 2) + 128 * hf + 32 * (hh & 3); }
            f32x4 wv[8]; float gv[8];
            const int nq = (lane & 7) * 4;
#pragma unroll
            for (int i = 0; i < 8; ++i) { const int kk = 8 * i + (lane >> 3); wv[i] = *(const f32x4*)(p.W + (size_t)(k0 + kk) * p.ld + sc + nq); gv[i] = p.gain ? p.gain[k0 + kk] : 1.f; }
#pragma unroll
            for (int i = 0; i < 8; ++i) { const int kk = 8 * i + (lane >> 3); LAS float* d = scr + kk * 33 + nq;
                d[0] = wv[i].x * gv[i]; d[1] = wv[i].y * gv[i]; d[2] = wv[i].z * gv[i]; d[3] = wv[i].w * gv[i]; }
            asm volatile("s_waitcnt lgkmcnt(0)" ::: "memory");
            const int c = lane & 7;
#pragma unroll
            for (int jj = 0; jj < 4; ++jj) { const int n = (lane >> 3) + 8 * jj; const LAS float* s = scr + (8 * c) * 33 + n;
                u32x4 o; o.x = pk2(s[0 * 33], s[1 * 33]); o.y = pk2(s[2 * 33], s[3 * 33]); o.z = pk2(s[4 * 33], s[5 * 33]); o.w = pk2(s[6 * 33], s[7 * 33]);
                *(u32x4*)(p.WT + (size_t)(dr + n) * p.ldd + p.kofs + k0 + 8 * c) = o; }
            asm volatile("s_waitcnt lgkmcnt(0)" ::: "memory");
        }
        rot = (rot + nitems) % NGW;
    }
    float2* tab64 = (float2*)(a->ws + WS_ROPE); float2* tab32 = (float2*)(a->ws + WS_ROPE + 512 * 1024);
    const int gt = gw * 64 + lane, NT = NGW * 64;
    for (int e = gt; e < SEQ * 48; e += NT) {
        const int pos = e / 48, r = e % 48; const int half = r < 32 ? 32 : 16, i = r < 32 ? r : r - 32;
        const float inv = ex2(-((float)i / (float)half) * 13.287712379549449f);
        const float ang = (float)pos * inv;
        const float k = rintf(ang * 0.15915494309189535f);
        float rr = fmaf(-k, 6.2831854820251465f, ang); rr = fmaf(-k, -1.7484555e-07f, rr);
        const float2 cs = make_float2(__cosf(rr), __sinf(rr));
        if (r < 32) tab64[pos * 32 + i] = cs; else tab32[pos * 16 + i] = cs;
    }
}

__device__ __forceinline__ void norm_phase(const float* x, bf16_t* xb, float* ss, int NGW, int wv_s) {
    const int tid = launder_tid(), lane = tid & 63, gw = blockIdx.x * 8 + __builtin_amdgcn_readfirstlane(tid >> 6);
    for (int m0 = gw * 4; m0 < MT; m0 += NGW * 4) {
        f32x4 v[4][4];
#pragma unroll
        for (int r = 0; r < 4; ++r) { const f32x4* xr = (const f32x4*)(x + (size_t)(m0 + r) * DM) + lane;
#pragma unroll
            for (int j = 0; j < 4; ++j) v[r][j] = xr[64 * j]; }
#pragma unroll
        for (int r = 0; r < 4; ++r) { const int m = m0 + r; float s = 0.f;
#pragma unroll
            for (int j = 0; j < 4; ++j) s += (v[r][j].x * v[r][j].x + v[r][j].y * v[r][j].y) + (v[r][j].z * v[r][j].z + v[r][j].w * v[r][j].w);
            const float tot = wave_sum(s);
            u32x2* o8 = (u32x2*)(xb + (size_t)m * DM) + lane;
#pragma unroll
            for (int j = 0; j < 4; ++j) { u32x2 w; w.x = pk2(v[r][j].x, v[r][j].y); w.y = pk2(v[r][j].z, v[r][j].w); o8[64 * j] = w; }
            if (lane < 16) ss[(size_t)m * 16 + lane] = (lane == 0) ? tot : 0.f; }
    }
}

__device__ __forceinline__ void unpack8(const u32x4 w, float (&f)[8]) { f[0] = bflo(w.x); f[1] = bfhi(w.x); f[2] = bflo(w.y); f[3] = bfhi(w.y); f[4] = bflo(w.z); f[5] = bfhi(w.z); f[6] = bflo(w.w); f[7] = bfhi(w.w); }
__device__ __forceinline__ u32x4 pack8(const float (&f)[8]) { u32x4 w; w.x = pk2(f[0], f[1]); w.y = pk2(f[2], f[3]); w.z = pk2(f[4], f[5]); w.w = pk2(f[6], f[7]); return w; }

constexpr int PNT = 4;
__device__ __forceinline__ void post_e2(KA a, int i, int NGW, int wv_s) {
    const int tid = launder_tid(), lane = tid & 63, gw = blockIdx.x * 8 + __builtin_amdgcn_readfirstlane(tid >> 6);
    bf16_t* P = (bf16_t*)(a->ws + WS_P);
    const float2* tab64 = (const float2*)(a->ws + WS_ROPE); const float2* tab32 = (const float2*)(a->ws + WS_ROPE + 512 * 1024);
    const float* gq = a->in[4] + i * 64; const float* gk = a->in[5] + i * 64;
    const float* gql = a->in[8] + i * 256; const float* gkv = a->in[10] + i * 128; const float* gkr = a->in[15] + i * 32;
    const int gI = lane >> 2, sub = lane & 3, e0 = sub * 8;
    const float* gn = (gI < 8) ? gq : gk;
    float g1[8], g2[8];
#pragma unroll
    for (int j = 0; j < 8; ++j) { g1[j] = gn[e0 + j]; g2[j] = gn[32 + e0 + j]; }
    const float qs = (gI < 8) ? 0.125f * LOG2E : 1.f;
    const f32x4 gql4 = *(const f32x4*)(gql + 4 * lane);
    const float gkv0 = gkv[2 * lane], gkv1 = gkv[2 * lane + 1];
    const int ii = lane & 15;
    const float gkr0 = gkr[ii], gkr1 = gkr[ii + 16];
    for (int m0 = gw * PNT; m0 < MT; m0 += NGW * PNT) {
        u32x4 A1[PNT], A2[PNT]; u32x2 Bq[PNT]; unsigned Ckv[PNT]; unsigned short D1[PNT], D2[PNT]; float2 T32[PNT];
#pragma unroll
        for (int t = 0; t < PNT; ++t) { bf16_t* row = P + (size_t)(m0 + t) * 1536; const int pos = (m0 + t) & (SEQ - 1);
            A1[t] = *(const u32x4*)(row + gI * 64 + e0); A2[t] = *(const u32x4*)(row + gI * 64 + e0 + 32);
            Bq[t] = *(const u32x2*)(row + 1024 + 4 * lane); Ckv[t] = *((const unsigned*)(row + 1280) + lane);
            D1[t] = row[1408 + ii]; D2[t] = row[1408 + 16 + ii]; T32[t] = tab32[pos * 16 + ii]; }
#pragma unroll
        for (int t = 0; t < PNT; ++t) {
            bf16_t* row = P + (size_t)(m0 + t) * 1536; const int pos = (m0 + t) & (SEQ - 1);
            {
                float x1[8], x2[8]; unpack8(A1[t], x1); unpack8(A2[t], x2);
                float ss = 0.f;
#pragma unroll
                for (int j = 0; j < 8; ++j) ss += x1[j] * x1[j] + x2[j] * x2[j];
                ss += SWZ_XOR(ss, 1); ss += SWZ_XOR(ss, 2);
                const float rstd = rsqrtf(ss * (1.f / 64.f) + EPS);
                float o1[8], o2[8];
                const f32x4* tp = (const f32x4*)(tab64 + pos * 32 + e0);
#pragma unroll
                for (int j2 = 0; j2 < 4; ++j2) { const f32x4 cs = tp[j2];
                    { const int j = 2 * j2; const float y1 = x1[j] * rstd * g1[j], y2 = x2[j] * rstd * g2[j]; o1[j] = (y1 * cs.x - y2 * cs.y) * qs; o2[j] = (y2 * cs.x + y1 * cs.y) * qs; }
                    { const int j = 2 * j2 + 1; const float y1 = x1[j] * rstd * g1[j], y2 = x2[j] * rstd * g2[j]; o1[j] = (y1 * cs.z - y2 * cs.w) * qs; o2[j] = (y2 * cs.z + y1 * cs.w) * qs; } }
                *(u32x4*)(row + gI * 64 + e0) = pack8(o1); *(u32x4*)(row + gI * 64 + e0 + 32) = pack8(o2);
            }
            {
                const u32x2 w = Bq[t];
                const float x0 = bflo(w.x), x1 = bfhi(w.x), x2 = bflo(w.y), x3 = bfhi(w.y);
                const float rstd = rsqrtf(wave_sum(x0 * x0 + x1 * x1 + x2 * x2 + x3 * x3) * (1.f / 256.f) + EPS);
                u32x2 o; o.x = pk2(x0 * rstd * gql4.x, x1 * rstd * gql4.y); o.y = pk2(x2 * rstd * gql4.z, x3 * rstd * gql4.w); *(u32x2*)(row + 1024 + 4 * lane) = o;
            }
            {
                const unsigned w = Ckv[t]; const float x0 = bflo(w), x1 = bfhi(w);
                const float rstd = rsqrtf(wave_sum(x0 * x0 + x1 * x1) * (1.f / 128.f) + EPS);
                *((unsigned*)(row + 1280) + lane) = pk2(x0 * rstd * gkv0, x1 * rstd * gkv1);
            }
            {
                const float x1 = __uint_as_float((unsigned)D1[t] << 16), x2 = __uint_as_float((unsigned)D2[t] << 16);
                float ss = x1 * x1 + x2 * x2;
                ss += SWZ_XOR(ss, 1); ss += SWZ_XOR(ss, 2); ss += SWZ_XOR(ss, 4); ss += SWZ_XOR(ss, 8);
                const float rstd = rsqrtf(ss * (1.f / 32.f) + EPS);
                const float2 cs = T32[t]; const float y1 = x1 * rstd * gkr0, y2 = x2 * rstd * gkr1;
                const unsigned r1 = pk2(y1 * cs.x - y2 * cs.y, 0.f), r2 = pk2(y2 * cs.x + y1 * cs.y, 0.f);
                if (lane < 16) { row[1408 + ii] = (bf16_t)(r1 & 0xffffu); row[1408 + 16 + ii] = (bf16_t)(r2 & 0xffffu); }
            }
        }
    }
}

__device__ __forceinline__ void post_e4(KA a, int i, int NGW, int wv_s) {
    const int tid = launder_tid(), lane = tid & 63, gw = blockIdx.x * 8 + __builtin_amdgcn_readfirstlane(tid >> 6);
    bf16_t* QB = (bf16_t*)(a->ws + WS_QB);
    const float2* tab32 = (const float2*)(a->ws + WS_ROPE + 512 * 1024);
    const float* gqn = a->in[12] + i * 64; const float* gqr = a->in[13] + i * 32; const float* gkn = a->in[14] + i * 64;
    const int h = lane >> 3, sub = lane & 7;
    float gq8[8], gk8[8];
#pragma unroll
    for (int j = 0; j < 8; ++j) { gq8[j] = gqn[sub * 8 + j]; gk8[j] = gkn[sub * 8 + j]; }
    const float gr0 = gqr[2 * sub], gr1 = gqr[2 * sub + 1], gr2 = gqr[16 + 2 * sub], gr3 = gqr[16 + 2 * sub + 1];
    const float CB = 0.10206207261596575f * LOG2E;
    for (int m0 = gw * PNT; m0 < MT; m0 += NGW * PNT) {
        u32x4 QN[PNT], KNv[PNT]; unsigned W1[PNT], W2[PNT]; f32x4 TC[PNT];
#pragma unroll
        for (int t = 0; t < PNT; ++t) { bf16_t* row = QB + (size_t)(m0 + t) * 1280; const int pos = (m0 + t) & (SEQ - 1);
            QN[t] = *(const u32x4*)(row + h * 96 + sub * 8); KNv[t] = *(const u32x4*)(row + 768 + h * 64 + sub * 8);
            const unsigned* p = (const unsigned*)(row + h * 96 + 64) + sub; W1[t] = p[0]; W2[t] = p[8];
            TC[t] = *(const f32x4*)(tab32 + pos * 16 + 2 * sub); }
#pragma unroll
        for (int t = 0; t < PNT; ++t) {
            bf16_t* row = QB + (size_t)(m0 + t) * 1280;
            {
                float x[8]; unpack8(QN[t], x);
                float ss = 0.f;
#pragma unroll
                for (int j = 0; j < 8; ++j) ss += x[j] * x[j];
                ss += SWZ_XOR(ss, 1); ss += SWZ_XOR(ss, 2); ss += SWZ_XOR(ss, 4);
                const float rstd = rsqrtf(ss * (1.f / 64.f) + EPS) * CB;
#pragma unroll
                for (int j = 0; j < 8; ++j) x[j] = x[j] * rstd * gq8[j];
                *(u32x4*)(row + h * 96 + sub * 8) = pack8(x);
            }
            {
                unsigned* p = (unsigned*)(row + h * 96 + 64) + sub; const unsigned w1 = W1[t], w2 = W2[t];
                const float a0 = bflo(w1), a1 = bfhi(w1), b0 = bflo(w2), b1 = bfhi(w2);
                float ss = a0 * a0 + a1 * a1 + b0 * b0 + b1 * b1;
                ss += SWZ_XOR(ss, 1); ss += SWZ_XOR(ss, 2); ss += SWZ_XOR(ss, 4);
                const float rstd = rsqrtf(ss * (1.f / 32.f) + EPS);
                const f32x4 c = TC[t];
                const float ya0 = a0 * rstd * gr0, ya1 = a1 * rstd * gr1, yb0 = b0 * rstd * gr2, yb1 = b1 * rstd * gr3;
                p[0] = pk2((ya0 * c.x - yb0 * c.y) * CB, (ya1 * c.z - yb1 * c.w) * CB);
                p[8] = pk2((yb0 * c.x + ya0 * c.y) * CB, (yb1 * c.z + ya1 * c.w) * CB);
            }
            {
                float x[8]; unpack8(KNv[t], x);
                float ss = 0.f;
#pragma unroll
                for (int j = 0; j < 8; ++j) ss += x[j] * x[j];
                ss += SWZ_XOR(ss, 1); ss += SWZ_XOR(ss, 2); ss += SWZ_XOR(ss, 4);
                const float rstd = rsqrtf(ss * (1.f / 64.f) + EPS);
#pragma unroll
                for (int j = 0; j < 8; ++j) x[j] = x[j] * rstd * gk8[j];
                *(u32x4*)(row + 768 + h * 64 + sub * 8) = pack8(x);
            }
        }
    }
}

template <int DK, int DV> struct AttnGeo {
    static constexpr int KS = DK * 2 + 16, KBYTES = 64 * KS, VS = 136, VBYTES = DV * VS;
    static constexpr int KOFF = 0, VOFF = 2 * KBYTES;
};
template <int DK> __device__ __forceinline__ int kchunk_off(int dc) { return 8 * dc; }
template <int DK, int DV>
__device__ __forceinline__ void stage_load(int tid, int j, const bf16_t* K1, int ldk1, const bf16_t* K2, int ldk2, const bf16_t* Vt, u32x4& kr0, u32x4& kr1, u32x4& vr0, u32x4& vr1) {
    constexpr int CPR = DK / 8;
    { const int c = tid, key = c / CPR, dc = c % CPR;
      const bf16_t* src = (DK == 64 || dc < 8) ? K1 + (size_t)(64 * j + key) * ldk1 + kchunk_off<DK>(dc) : K2 + (size_t)(64 * j + key) * ldk2 + (dc - 8) * 8;
      kr0 = *(const u32x4*)src; }
    if (DK == 96) { if (tid < 256) { const int c = tid + 512, key = c / CPR, dc = c % CPR;
      const bf16_t* src = (dc < 8) ? K1 + (size_t)(64 * j + key) * ldk1 + kchunk_off<DK>(dc) : K2 + (size_t)(64 * j + key) * ldk2 + (dc - 8) * 8;
      kr1 = *(const u32x4*)src; } }
    { const int c = tid, d = c >> 3, kc = c & 7; vr0 = *(const u32x4*)(Vt + (size_t)d * MT + 64 * j + kc * 8); }
    if (DV == 128) { const int c = tid + 512, d = c >> 3, kc = c & 7; vr1 = *(const u32x4*)(Vt + (size_t)d * MT + 64 * j + kc * 8); }
}
template <int DK, int DV>
__device__ __forceinline__ void stage_store(int tid, LAS unsigned char* Kb, LAS unsigned char* Vb, const u32x4& kr0, const u32x4& kr1, const u32x4& vr0, const u32x4& vr1) {
    typedef AttnGeo<DK, DV> G; constexpr int CPR = DK / 8;
    { const int c = tid, key = c / CPR, dc = c % CPR; *(LAS u32x4*)(Kb + key * G::KS + dc * 16) = kr0; }
    if (DK == 96) { if (tid < 256) { const int c = tid + 512, key = c / CPR, dc = c % CPR; *(LAS u32x4*)(Kb + key * G::KS + dc * 16) = kr1; } }
    { const int c = tid, d = c >> 3, kc = c & 7; LAS u32x2* p = (LAS u32x2*)(Vb + d * G::VS + kc * 16); p[0] = (u32x2){vr0.x, vr0.y}; p[1] = (u32x2){vr0.z, vr0.w}; }
    if (DV == 128) { const int c = tid + 512, d = c >> 3, kc = c & 7; LAS u32x2* p = (LAS u32x2*)(Vb + d * G::VS + kc * 16); p[0] = (u32x2){vr1.x, vr1.y}; p[1] = (u32x2){vr1.z, vr1.w}; }
}
template <int DK>
__device__ __forceinline__ void qk_tile(const LAS unsigned char* Kb, int KS, const bf16x8 (&Qf)[DK / 16], int r32, int hi, f32x16& S0, f32x16& S1, float init = 0.f) {
#pragma unroll
    for (int i = 0; i < 16; ++i) { S0[i] = init; S1[i] = init; }
#pragma unroll
    for (int kk = 0; kk < DK / 16; ++kk) {
        const bf16x8 a0 = *(const LAS bf16x8*)(Kb + r32 * KS + kk * 32 + hi * 16);
        const bf16x8 a1 = *(const LAS bf16x8*)(Kb + (32 + r32) * KS + kk * 32 + hi * 16);
        S0 = __builtin_amdgcn_mfma_f32_32x32x16_bf16(a0, Qf[kk], S0, 0, 0, 0);
        S1 = __builtin_amdgcn_mfma_f32_32x32x16_bf16(a1, Qf[kk], S1, 0, 0, 0);
    }
}
template <int DV>
__device__ __forceinline__ void pv_tile(const LAS unsigned char* Vb, const f32x16& P0, const f32x16& P1, int r32, int hi, f32x16 (&O)[DV / 32]) {
#pragma unroll
    for (int T = 0; T < 2; ++T)
#pragma unroll
        for (int jj = 0; jj < 2; ++jj) {
            const f32x16& Pt = T ? P1 : P0;
            u32x4 pw; pw.x = pk2(Pt[8 * jj + 0], Pt[8 * jj + 1]); pw.y = pk2(Pt[8 * jj + 2], Pt[8 * jj + 3]); pw.z = pk2(Pt[8 * jj + 4], Pt[8 * jj + 5]); pw.w = pk2(Pt[8 * jj + 6], Pt[8 * jj + 7]);
            const bf16x8 pb = __builtin_bit_cast(bf16x8, pw);
#pragma unroll
            for (int dd = 0; dd < DV / 32; ++dd) {
                const LAS unsigned char* vp = Vb + (32 * dd + r32) * 136 + (32 * T + 16 * jj + 4 * hi) * 2;
                const u32x2 lo = *(const LAS u32x2*)vp, h2 = *(const LAS u32x2*)(vp + 16);
                const u32x4 vw = {lo.x, lo.y, h2.x, h2.y};
                O[dd] = __builtin_amdgcn_mfma_f32_32x32x16_bf16(__builtin_bit_cast(bf16x8, vw), pb, O[dd], 0, 0, 0);
            }
        }
}

template <int DK, int DV, bool FIXED>
__device__ __forceinline__ void attn_sm_pass(LAS unsigned char* lds, int tid, int wave, int lane, const bf16_t* Qp, int ldq, const bf16_t* K1, int ldk1, const bf16_t* K2, int ldk2,
                                             const bf16_t* Vt, int u, float shift, int qrope_off, f32x16 (&O)[DV / 32], float& lsum) {
    typedef AttnGeo<DK, DV> G;
    const int r32 = lane & 31, hi = lane >> 5;
    bf16x8 Qf[DK / 16];
    { const bf16_t* qp = Qp + (size_t)(256 * u + 32 * wave + r32) * ldq + 8 * hi;
#pragma unroll
      for (int kk = 0; kk < DK / 16; ++kk) { const int off = 16 * kk; Qf[kk] = *(const bf16x8*)(qp + off); } }
#pragma unroll
    for (int dd = 0; dd < DV / 32; ++dd)
#pragma unroll
        for (int i = 0; i < 16; ++i) O[dd][i] = 0.f;
    float mrun = -INFINITY, l = 0.f;
    const int ntiles = 4 * u + 4, jw = 4 * u + (wave >> 1);
    u32x4 kr0, kr1, vr0, vr1;
    stage_load<DK, DV>(tid, 0, K1, ldk1, K2, ldk2, Vt, kr0, kr1, vr0, vr1);
    stage_store<DK, DV>(tid, lds + G::KOFF, lds + G::VOFF, kr0, kr1, vr0, vr1);
    __syncthreads();
    for (int j = 0; j < ntiles; ++j) {
        const int cb = j & 1;
        if (j + 1 < ntiles) stage_load<DK, DV>(tid, j + 1, K1, ldk1, K2, ldk2, Vt, kr0, kr1, vr0, vr1);
        if (j <= jw) {
            const LAS unsigned char* Kb = lds + G::KOFF + cb * G::KBYTES; const LAS unsigned char* Vb = lds + G::VOFF + cb * G::VBYTES;
            f32x16 S0, S1;
            if (FIXED) {
                qk_tile<DK>(Kb, G::KS, Qf, r32, hi, S0, S1, -shift);
                float ps = 0.f;
#pragma unroll
                for (int i = 0; i < 16; ++i) { S0[i] = ex2(S0[i]); S1[i] = ex2(S1[i]); ps += S0[i] + S1[i]; }
                l += ps;
            } else {
                qk_tile<DK>(Kb, G::KS, Qf, r32, hi, S0, S1);
                float mx = fmaxf(S0[0], S1[0]);
#pragma unroll
                for (int i = 1; i < 16; ++i) mx = fmaxf(mx, fmaxf(S0[i], S1[i]));
                mx = x32_max(mx);
                const float mnew = fmaxf(mrun, mx), alpha = ex2(mrun - mnew); mrun = mnew;
                float ps = 0.f;
#pragma unroll
                for (int i = 0; i < 16; ++i) { S0[i] = ex2(S0[i] - mnew); S1[i] = ex2(S1[i] - mnew); ps += S0[i] + S1[i]; }
                l = l * alpha + ps;
#pragma unroll
                for (int dd = 0; dd < DV / 32; ++dd) O[dd] = O[dd] * alpha;
            }
            pv_tile<DV>(Vb, S0, S1, r32, hi, O);
        }
        if (j + 1 < ntiles) stage_store<DK, DV>(tid, lds + G::KOFF + (cb ^ 1) * G::KBYTES, lds + G::VOFF + (cb ^ 1) * G::VBYTES, kr0, kr1, vr0, vr1);
        __syncthreads();
    }
    lsum = x32_sum(l);
}

__device__ __forceinline__ float wave_max(float v) {
    v = fmaxf(v, SWZ_XOR(v, 1)); v = fmaxf(v, SWZ_XOR(v, 2)); v = fmaxf(v, SWZ_XOR(v, 4)); v = fmaxf(v, SWZ_XOR(v, 8)); v = fmaxf(v, SWZ_XOR(v, 16));
    return x32_max(v);
}
__device__ __forceinline__ void store_o32(bf16_t* rowp  , const f32x16& v, int hi) {
#pragma unroll
    for (int gp = 0; gp < 2; ++gp) { const int g = 2 * gp;
        unsigned ax = pk2(v[4 * g], v[4 * g + 1]), ay = pk2(v[4 * g + 2], v[4 * g + 3]), bx = pk2(v[4 * g + 4], v[4 * g + 5]), by = pk2(v[4 * g + 6], v[4 * g + 7]);
        { auto r = __builtin_amdgcn_permlane32_swap(ax, bx, false, false); ax = r[0]; bx = r[1]; }
        { auto r = __builtin_amdgcn_permlane32_swap(ay, by, false, false); ay = r[0]; by = r[1]; }
        *(u32x4*)(rowp + 16 * gp + (hi ? 8 : 0)) = (u32x4){ax, ay, bx, by}; }
}
__device__ __forceinline__ void attn_a_unit(KA a, LAS unsigned char* lds, int i, int l, int b, int h, int u, int wv_s) {
    const int tid = launder_tid(), lane = tid & 63, wave = __builtin_amdgcn_readfirstlane(tid >> 6);
    const float bound = uni(8.f * LOG2E * 1.01f * wave_max(fabsf(a->in[4][i * 64 + lane])) * wave_max(fabsf(a->in[5][i * 64 + lane])));
    const bf16_t* P = (const bf16_t*)(a->ws + WS_P); const bf16_t* VtA = (const bf16_t*)(a->ws + WS_VTA); bf16_t* MIX = (bf16_t*)(a->ws + WS_MIX);
    const bf16_t* Pb = P + (size_t)b * SEQ * 1536; const bf16_t* Vt = VtA + (size_t)(h * 128) * MT + (size_t)b * SEQ;
    const float lam0 = 0.8f - 0.6f * expf(-0.3f * (float)l);
    f32x16 O[4], O1[4];
#pragma nounroll
    for (int half = 0; half < 2; ++half) {
        float ls;
        if (bound < 40.f) attn_sm_pass<64, 128, true>(lds, tid, wave, lane, Pb + h * 128 + half * 64, 1536, Pb + 512 + h * 128 + half * 64, 1536, nullptr, 0, Vt, u, bound, 0, O, ls);
        else attn_sm_pass<64, 128, false>(lds, tid, wave, lane, Pb + h * 128 + half * 64, 1536, Pb + 512 + h * 128 + half * 64, 1536, nullptr, 0, Vt, u, 0.f, 0, O, ls);
        if (half == 0) { const float r = 1.f / ls;
#pragma unroll
            for (int dd = 0; dd < 4; ++dd) O1[dd] = O[dd] * r; }
        else { const float* lf = a->in[6] + i * 256; const int ln = launder_tid() & 63;
            const float s1 = wave_sum(lf[ln] * lf[64 + ln]), s2 = wave_sum(lf[128 + ln] * lf[192 + ln]);
            const float lam = uni(expf(s1) - expf(s2) + lam0);
            const float r2 = lam / ls;
#pragma unroll
            for (int dd = 0; dd < 4; ++dd) O1[dd] = O1[dd] - O[dd] * r2; }
    }
    float ss = 0.f;
#pragma unroll
    for (int dd = 0; dd < 4; ++dd)
#pragma unroll
        for (int e = 0; e < 16; ++e) ss += O1[dd][e] * O1[dd][e];
    ss = x32_sum(ss);
    const float rstd = rsqrtf(ss * (1.f / 128.f) + EPS) * (1.f - lam0);
    const float* gout = a->in[7] + i * 128;
    const int lane2 = launder_tid() & 63, r32 = lane2 & 31, hi = lane2 >> 5;
    bf16_t* orow = MIX + (size_t)(b * SEQ + 256 * u + 32 * wave + r32) * 1024 + h * 128;
#pragma unroll
    for (int dd = 0; dd < 4; ++dd) {
#pragma unroll
        for (int g = 0; g < 4; ++g) { const f32x4 gv = *(const f32x4*)(gout + 32 * dd + 8 * g + 4 * hi);
            O1[dd][4 * g] *= rstd * gv.x; O1[dd][4 * g + 1] *= rstd * gv.y; O1[dd][4 * g + 2] *= rstd * gv.z; O1[dd][4 * g + 3] *= rstd * gv.w; }
        store_o32(orow + 32 * dd, O1[dd], hi); }
}
__device__ __forceinline__ void attn_b_unit(KA a, LAS unsigned char* lds, int i, int b, int h, int u, int wv_s) {
    const int tid = launder_tid(), lane = tid & 63, wave = __builtin_amdgcn_readfirstlane(tid >> 6);
    const float mqn = wave_max(fabsf(a->in[12][i * 64 + lane])), mkn = wave_max(fabsf(a->in[14][i * 64 + lane]));
    const float mqr = wave_max(fabsf(a->in[13][i * 32 + (lane & 31)])), mkr = wave_max(fabsf(a->in[15][i * 32 + (lane & 31)]));
    const float bound = (64.f * mqn * mkn + 32.f * mqr * mkr) * 0.10206207261596575f * LOG2E * 1.01f;
    const bf16_t* P = (const bf16_t*)(a->ws + WS_P); const bf16_t* QB = (const bf16_t*)(a->ws + WS_QB); const bf16_t* KN = QB + 768;
    const bf16_t* VtB = (const bf16_t*)(a->ws + WS_VTB); bf16_t* MIX = (bf16_t*)(a->ws + WS_MIX);
    f32x16 O[2]; float l;
    const int qrope_off = 0;
    if (bound < 40.f) attn_sm_pass<96, 64, true>(lds, tid, wave, lane, QB + (size_t)b * SEQ * 1280 + h * 96, 1280, KN + (size_t)b * SEQ * 1280 + h * 64, 1280, P + (size_t)b * SEQ * 1536 + 1408, 1536,
                         VtB + (size_t)(h * 64) * MT + (size_t)b * SEQ, u, bound, qrope_off, O, l);
    else attn_sm_pass<96, 64, false>(lds, tid, wave, lane, QB + (size_t)b * SEQ * 1280 + h * 96, 1280, KN + (size_t)b * SEQ * 1280 + h * 64, 1280, P + (size_t)b * SEQ * 1536 + 1408, 1536,
                         VtB + (size_t)(h * 64) * MT + (size_t)b * SEQ, u, 0.f, qrope_off, O, l);
    const float r = 1.f / l; const int r32 = lane & 31, hi = lane >> 5;
    bf16_t* orow = MIX + (size_t)(b * SEQ + 256 * u + 32 * wave + r32) * 1024 + 512 + h * 64;
#pragma unroll
    for (int dd = 0; dd < 2; ++dd) { O[dd] = O[dd] * r; store_o32(orow + 32 * dd, O[dd], hi); }
}
__device__ __forceinline__ void attn_c_unit(KA a, LAS unsigned char* lds, int b, int h, int u, int wv_s) {
    const int tid = launder_tid(), lane = tid & 63, wave = __builtin_amdgcn_readfirstlane(tid >> 6);
    typedef AttnGeo<64, 64> G;
    const bf16_t* QK = (const bf16_t*)(a->ws + WS_QK) + (size_t)b * SEQ * 2048; const bf16_t* K1 = QK + 1024 + h * 64;
    const bf16_t* Vt = (const bf16_t*)(a->ws + WS_VTC) + (size_t)(h * 64) * MT + (size_t)b * SEQ; bf16_t* MIX = (bf16_t*)(a->ws + WS_MIX);
    const int r32 = lane & 31, hi = lane >> 5;
    const int qpos = 256 * u + 32 * wave + r32;
    bf16x8 Qf[4];
    { const bf16_t* qp = QK + (size_t)qpos * 2048 + h * 64 + 8 * hi;
#pragma unroll
      for (int kk = 0; kk < 4; ++kk) Qf[kk] = *(const bf16x8*)(qp + 16 * kk); }
    f32x16 O[2];
#pragma unroll
    for (int dd = 0; dd < 2; ++dd)
#pragma unroll
        for (int e = 0; e < 16; ++e) O[dd][e] = 0.f;
    float trun = 1.f;
    const float STICK_TINY = 1e-37f;
    bool wdone = false;
    const int ntiles = 4 * u + 4, jw = 4 * u + (wave >> 1);
    u32x4 kr0, kr1, vr0, vr1;
    stage_load<64, 64>(tid, ntiles - 1, K1, 2048, nullptr, 0, Vt, kr0, kr1, vr0, vr1);
    stage_store<64, 64>(tid, lds + G::KOFF, lds + G::VOFF, kr0, kr1, vr0, vr1);
    __syncthreads();
    for (int idx = 0; idx < ntiles; ++idx) {
        const int j = ntiles - 1 - idx, cb = idx & 1;
        if (j > 0) stage_load<64, 64>(tid, j - 1, K1, 2048, nullptr, 0, Vt, kr0, kr1, vr0, vr1);
        if (j <= jw && !wdone) {
            const LAS unsigned char* Kb = lds + G::KOFF + cb * G::KBYTES; const LAS unsigned char* Vb = lds + G::VOFF + cb * G::VBYTES;
            f32x16 Z0, Z1;
            qk_tile<64>(Kb, G::KS, Qf, r32, hi, Z0, Z1);
            const bool diag = (j == jw); const int kbase = 64 * j + 4 * hi;
#pragma unroll
            for (int e = 0; e < 16; ++e) {
                const int key = kbase + 8 * (e >> 2) + (e & 3);
                float a0 = __builtin_amdgcn_rcpf(1.f + ex2(Z0[e])), a1 = __builtin_amdgcn_rcpf(1.f + ex2(Z1[e]));
                if (diag) { if (key >= qpos) a0 = 1.f; if (key + 32 >= qpos) a1 = 1.f; }
                Z0[e] = a0; Z1[e] = a1;
            }
            float seg[8], slo[8], sup[8];
#pragma unroll
            for (int g = 0; g < 4; ++g) { seg[g] = (Z0[4 * g] * Z0[4 * g + 1]) * (Z0[4 * g + 2] * Z0[4 * g + 3]); seg[4 + g] = (Z1[4 * g] * Z1[4 * g + 1]) * (Z1[4 * g + 2] * Z1[4 * g + 3]); }
#pragma unroll
            for (int s = 0; s < 8; ++s) { auto r = __builtin_amdgcn_permlane32_swap(__float_as_uint(seg[s]), __float_as_uint(seg[s]), false, false); slo[s] = __uint_as_float(r[0]); sup[s] = __uint_as_float(r[1]); }
            float run = trun;
#pragma unroll
            for (int s = 7; s >= 0; --s) {
                float f = (hi == 0) ? run * sup[s] : run;
                run *= slo[s] * sup[s];
                f32x16& Z = (s >= 4) ? Z1 : Z0; const int g = s & 3;
#pragma unroll
                for (int r = 3; r >= 0; --r) { const float fn = f * Z[4 * g + r]; Z[4 * g + r] = f - fn; f = fn; }
            }
            trun = run;
            pv_tile<64>(Vb, Z0, Z1, r32, hi, O);
            wdone = (__ballot(trun >= STICK_TINY) == 0ull);
        }
        if (j > 0) stage_store<64, 64>(tid, lds + G::KOFF + (cb ^ 1) * G::KBYTES, lds + G::VOFF + (cb ^ 1) * G::VBYTES, kr0, kr1, vr0, vr1);
        {
            volatile LAS unsigned* fl = (volatile LAS unsigned*)(lds + 131072 + 32 + (idx & 1) * 32);
            if (lane == 0) fl[wave] = wdone ? 1u : 0u;
            __syncthreads();
            const unsigned all = fl[0] & fl[1] & fl[2] & fl[3] & fl[4] & fl[5] & fl[6] & fl[7];
            if (all) break;
        }
    }
    bf16_t* orow = MIX + (size_t)(b * SEQ + qpos) * 1024 + h * 64;
#pragma unroll
    for (int dd = 0; dd < 2; ++dd) store_o32(orow + 32 * dd, O[dd], hi);
}


#define XB_TMO      128
#define XB_XCNT(j)  (256  + 64 * (j))
#define XB_XSUB(j)  (1280 + 64 * (j))
#define XB_XGEN(j)  (2304 + 64 * (j))
#define XB_TOP      3328
#define XB_TOPGEN   3392
#define XCD_BAR_WORDS 3456
#define XB_SPIN_CAP (1u << 18)
__device__ __forceinline__ unsigned xb_ld(unsigned* p)              { return __hip_atomic_load(p, __ATOMIC_RELAXED, __HIP_MEMORY_SCOPE_AGENT); }
__device__ __forceinline__ unsigned xb_add(unsigned* p, unsigned v) { return __hip_atomic_fetch_add(p, v, __ATOMIC_RELAXED, __HIP_MEMORY_SCOPE_AGENT); }
__device__ __forceinline__ unsigned xb_xcc_id() { return (unsigned)__builtin_amdgcn_s_getreg((3 << 11) | 20) & 0xFu; }
#define XB_SPIN(cond, bar) do { unsigned _sp = 0; while (cond) { __builtin_amdgcn_s_sleep(1); \
    if ((++_sp & 255u) == 0u) { if (xb_ld(&(bar)[XB_TMO])) break; if (_sp > XB_SPIN_CAP) { atomicAdd(&(bar)[XB_TMO], 1u); break; } } } } while (0)
struct XcdBarrier { unsigned* bar; unsigned x; volatile LAS unsigned* st; };
__device__ __forceinline__ XcdBarrier xcd_barrier_post(unsigned* bar, volatile LAS unsigned* st) {
    XcdBarrier b; b.bar = bar; b.x = xb_xcc_id(); b.st = st;
    if (threadIdx.x == 0) (void)xb_add(&bar[XB_XCNT(b.x)], 1u);
    return b;
}
__device__ __forceinline__ void xcd_barrier_complete(unsigned* bar, unsigned x, unsigned& nloc, unsigned& nx) {
    const unsigned G = gridDim.x * gridDim.y * gridDim.z;
    unsigned sum, cnt, mine, sp = 0u;
    for (;;) {
        sum = 0u; cnt = 0u; mine = 0u;
#pragma unroll
        for (unsigned j = 0; j < 16; ++j) { const unsigned c = xb_ld(&bar[XB_XCNT(j)]); sum += c; cnt += (c > 0u) ? 1u : 0u; mine = (j == x) ? c : mine; }
        if (sum == G) break;
        __builtin_amdgcn_s_sleep(1);
        if ((++sp & 255u) == 0u) { if (xb_ld(&bar[XB_TMO])) break; if (sp > XB_SPIN_CAP) { atomicAdd(&bar[XB_TMO], 1u); break; } }
    }
    nloc = mine > 0u ? mine : 1u; nx = cnt > 0u ? cnt : 1u;
}
__device__ __forceinline__ void xcd_barrier(const XcdBarrier& b, int tid) {
    asm volatile("s_waitcnt vmcnt(0)" ::: "memory");
    __syncthreads();
    if (tid == 0) {
        unsigned* bar = b.bar;
        __builtin_amdgcn_s_waitcnt(0);
        unsigned nloc = b.st[0], nx = b.st[1];
        if (nloc == 0u) { xcd_barrier_complete(bar, b.x, nloc, nx); b.st[0] = nloc; b.st[1] = nx; }
        const unsigned old = xb_add(&bar[XB_XSUB(b.x)], 1u);
        const unsigned gen = old / nloc;
        if (old + 1u == (gen + 1u) * nloc) {
            __builtin_amdgcn_fence(__ATOMIC_RELEASE, "agent");
            asm volatile("s_waitcnt vmcnt(0)" ::: "memory");
            const unsigned og = xb_add(&bar[XB_TOP], 1u);
            const unsigned tg = og / nx;
            if (og + 1u == (tg + 1u) * nx) xb_add(&bar[XB_TOPGEN], 1u);
            else XB_SPIN(xb_ld(&bar[XB_TOPGEN]) == tg, bar);
            __builtin_amdgcn_fence(__ATOMIC_ACQUIRE, "agent");
            xb_add(&bar[XB_XGEN(b.x)], 1u);
            asm volatile("s_waitcnt vmcnt(0)" ::: "memory");
        } else {
            XB_SPIN(xb_ld(&bar[XB_XGEN(b.x)]) == gen, bar);
            __builtin_amdgcn_fence(__ATOMIC_ACQUIRE, "agent");
            asm volatile("s_waitcnt vmcnt(0)" ::: "memory");
        }
    }
    __syncthreads();
}

__global__ void __launch_bounds__(512, 2) fwd_megakernel(Args a_unused) {
    extern __shared__ __attribute__((aligned(16))) unsigned char lds_raw[];
    LAS unsigned char* lds = (LAS unsigned char*)lds_raw;
    cg::grid_group grid = cg::this_grid();
    const int G = gridDim.x, bid = blockIdx.x, NGW = G * 8;
    const int wv_s = __builtin_amdgcn_readfirstlane(threadIdx.x >> 6);
    if (threadIdx.x < 32) ((LAS unsigned*)(lds + 131072))[threadIdx.x] = 0u;
    __syncthreads();
    if (blockIdx.x == 0) { unsigned* bw = (unsigned*)(ka_get()->ws + WS_CTL); for (int q = threadIdx.x; q < XCD_BAR_WORDS; q += 512) __hip_atomic_store(bw + q, 0u, __ATOMIC_RELAXED, __HIP_MEMORY_SCOPE_AGENT); }
#define GSYNC() do { XcdBarrier xb_; xb_.bar = (unsigned*)(ka_get()->ws + WS_CTL); xb_.x = xb_xcc_id(); xb_.st = (volatile LAS unsigned*)(lds + 131072); xcd_barrier(xb_, launder_tid()); } while (0)
#define WSP (ka_get()->ws)
#define OUTP (ka_get()->out)

    prep_phase(ka_get(), lds, NGW, wv_s);
    { KA a = ka_get(); norm_phase(a->in[0], (bf16_t*)(a->ws + WS_XB), (float*)(a->ws + WS_SS), NGW, wv_s); }
    grid.sync();
    (void)xcd_barrier_post((unsigned*)(ka_get()->ws + WS_CTL), (volatile LAS unsigned*)(lds + 131072));

    for (int l = 0; l < 4; ++l) {
        const int i = l >> 1;
        {
            const bool odd = (l & 1);
            for (int jb = 0; jb < 2; ++jb) {
                unsigned char* ws = WSP; const bf16_t* XB = (const bf16_t*)(ws + WS_XB);
                unsigned char* wb = odd ? ws + WS_ODD + i * ODD_STRIDE : ws + WS_EVEN + i * EVEN_STRIDE;
                const bf16_t *A, *Bt; int Mg, Ng; pg8::EpiStore E; pg8::StaticOrder S;
                if (jb == 0) { A = XB; Bt = (const bf16_t*)wb; Mg = MT; Ng = odd ? 2048 : 1536; E = pg8::EpiStore{(bf16_t*)(ws + WS_R), Ng, odd ? 0.125f * LOG2E : 1.f, odd ? 4 : 0, (const float*)(ws + WS_SS), 1}; }
                else { A = (const bf16_t*)(wb + (odd ? 4 : 3) * MiB); Bt = XB; Mg = odd ? 1024 : 512; Ng = MT; E = pg8::EpiStore{(bf16_t*)(ws + (odd ? WS_VTC : WS_VTA)), MT, 1.f, 0, (const float*)(ws + WS_SS), 2}; }
                S.init(Mg, Ng, G, bid);
                pg8::gemm_phase<pg8::EpiStore, 1024, 1024, 1024>(lds, A, Bt, S, E, wv_s);
            }
        }
        GSYNC();
        if ((l & 1) == 0) {
            post_e2(ka_get(), i, NGW, wv_s);
            GSYNC();
            {
                { unsigned char* ws = WSP; unsigned char* wb = ws + WS_EVEN + i * EVEN_STRIDE; const bf16_t* P = (const bf16_t*)(ws + WS_P);
                  KA a = ka_get();
                  pg8::EpiLatent E{(bf16_t*)(ws + WS_QB), a->in[12] + i * 64, a->in[13] + i * 32, a->in[14] + i * 64, (const float2*)(ws + WS_ROPE + 512 * 1024), 0.10206207261596575f * LOG2E, 0}; pg8::StaticOrder S; S.init(MT, 768, G, bid);
                  pg8::gemm_phase<pg8::EpiLatent, 256, 1536, 384>(lds, P + 1024, (const bf16_t*)(wb + 6 * MiB), S, E, wv_s); }
                { unsigned char* ws = WSP; unsigned char* wb = ws + WS_EVEN + i * EVEN_STRIDE; const bf16_t* P = (const bf16_t*)(ws + WS_P);
                  KA a = ka_get();
                  pg8::EpiLatent E{(bf16_t*)(ws + WS_QB), a->in[12] + i * 64, a->in[13] + i * 32, a->in[14] + i * 64, (const float2*)(ws + WS_ROPE + 512 * 1024), 0.10206207261596575f * LOG2E, 3}; pg8::StaticOrder S; S.init(MT, 512, G, bid);
                  pg8::gemm_phase<pg8::EpiLatent, 128, 1536, 384>(lds, P + 1280, (const bf16_t*)(wb + 6 * MiB) + 768 * 384 + 256, S, E, wv_s); }
                { unsigned char* ws = WSP; unsigned char* wb = ws + WS_EVEN + i * EVEN_STRIDE; const bf16_t* P = (const bf16_t*)(ws + WS_P);
                  pg8::EpiStore E{(bf16_t*)(ws + WS_VTB), MT, 1.f, 0, nullptr, 0}; pg8::StaticOrder S; S.init(512, MT, G, bid);
                  pg8::gemm_phase<pg8::EpiStore, 128, 384, 1536>(lds, (const bf16_t*)(wb + 6 * MiB + 960 * 1024) + 256, P + 1280, S, E, wv_s); }
            }
            GSYNC();
            {
                const int vb = (G % 8 == 0) ? (bid & 7) * (G >> 3) + (bid >> 3) : bid;
                for (int rep = 0; rep < ATT_REP; ++rep)
                for (int it = vb; it < 768; it += G) {
                    if (it < 256) { const int b = it >> 4, h = (it >> 2) & 3, up = it & 3;
                        for (int k = 0; k < 2; ++k) attn_a_unit(ka_get(), lds, i, l, b, h, k ? up : 7 - up, wv_s); }
                    else { const int p = it - 256, b = p >> 5, h = (p >> 2) & 7, up = p & 3;
                        for (int k = 0; k < 2; ++k) attn_b_unit(ka_get(), lds, i, b, h, k ? up : 7 - up, wv_s); }
                }
            }
        } else {
            const int vb = (G % 8 == 0) ? (bid & 7) * (G >> 3) + (bid >> 3) : bid;
            for (int rep = 0; rep < ATT_REP_O; ++rep)
            for (int it = vb; it < 1024; it += G) { const int b = it >> 6, h = (it >> 2) & 15, up = it & 3;
                for (int k = 0; k < 2; ++k) attn_c_unit(ka_get(), lds, b, h, k ? up : 7 - up, wv_s); }
        }
        GSYNC();
        {
            unsigned char* ws = WSP;
            const bf16_t* Wo = (l & 1) ? (const bf16_t*)(ws + WS_ODD + i * ODD_STRIDE + 6 * MiB) : (const bf16_t*)(ws + WS_EVEN + i * EVEN_STRIDE + 4 * MiB);
            pg8::EpiResid E{nullptr, 1024, (bf16_t*)(ws + WS_XB), (float*)(ws + WS_SS)}; pg8::StaticOrder S; S.init(MT, 1024, G, bid);
            pg8::gemm_phase<pg8::EpiResid, 1024, 1024, 1024>(lds, (const bf16_t*)(ws + WS_MIX), Wo, S, E, wv_s);
        }
        GSYNC();
        for (int rep = 0; rep < GU_REP; ++rep)
        { unsigned char* ws = WSP; unsigned char* wf = ws + WS_FFN + l * FFN_STRIDE;
          pg8::EpiSwiglu E{(bf16_t*)(ws + WS_ACT), DFF, (const float*)(ws + WS_SS)}; pg8::StaticOrder S; S.init(MT, 2 * DFF, G, bid);
          pg8::gemm_phase<pg8::EpiSwiglu, 1024, 1024, 1024>(lds, (const bf16_t*)(ws + WS_XB), (const bf16_t*)wf, S, E, wv_s); }
        GSYNC();
        { KA a = ka_get(); unsigned char* ws = a->ws; float* out = a->out; unsigned char* wf = ws + WS_FFN + l * FFN_STRIDE;
          pg8::EpiResid E{(l == 3) ? out : nullptr, 1024, (bf16_t*)(ws + WS_XB), (float*)(ws + WS_SS)}; pg8::StaticOrder S; S.init(MT, 1024, G, bid);
          pg8::gemm_phase<pg8::EpiResid, DFF, DFF, DFF>(lds, (const bf16_t*)(ws + WS_ACT), (const bf16_t*)(wf + 11 * MiB), S, E, wv_s); }
        GSYNC();
    }
}

extern "C" void kernel_launch(void* const* d_in, const int* in_sizes, int n_in, void* d_out, int out_size, void* d_ws, size_t ws_size, hipStream_t stream) {
    static int grid = 0;
    if (grid == 0) {
        if (n_in != 22 || ws_size < WS_END) { fprintf(stderr, "kernel_launch: unexpected n_in %d or ws_size %zu\n", n_in, ws_size); grid = -1; return; }
        int dev = 0, cus = 0, per_cu = 0;
        hipGetDevice(&dev);
        hipDeviceGetAttribute(&cus, hipDeviceAttributeMultiprocessorCount, dev);
        if (hipFuncSetAttribute((const void*)fwd_megakernel, hipFuncAttributeMaxDynamicSharedMemorySize, LDS_BYTES) != hipSuccess) { fprintf(stderr, "kernel_launch: hipFuncSetAttribute failed\n"); grid = -1; return; }
        hipOccupancyMaxActiveBlocksPerMultiprocessor(&per_cu, (const void*)fwd_megakernel, 512, LDS_BYTES);
        if (per_cu < 1) per_cu = 1;
        (void)hipGetLastError();
        grid = cus * per_cu;
    }
    if (grid < 0) return;
    Args a{};
    for (int i = 0; i < 22; ++i) a.in[i] = (const float*)d_in[i];
    a.out = (float*)d_out; a.ws = (unsigned char*)d_ws;
    void* args[] = {&a};
    hipError_t e = hipLaunchCooperativeKernel((const void*)fwd_megakernel, dim3(grid), dim3(512), args, LDS_BYTES, stream);
    if (e != hipSuccess) fprintf(stderr, "cooperative launch failed: %s (grid %d)\n", hipGetErrorString(e), grid);
}
```

```cpp
#include <hip/hip_runtime.h>
#include <hip/hip_cooperative_groups.h>
#include <cstdio>
#include <cstdint>
namespace cg = cooperative_groups;

#define LAS __attribute__((address_space(3)))
typedef unsigned short bf16_t;
typedef short bf16x8 __attribute__((ext_vector_type(8)));
typedef short s16x4 __attribute__((ext_vector_type(4)));
typedef float f32x4 __attribute__((ext_vector_type(4)));
typedef float f32x16 __attribute__((ext_vector_type(16)));
typedef unsigned u32x4 __attribute__((ext_vector_type(4)));
typedef unsigned u32x2 __attribute__((ext_vector_type(2)));
typedef float f32x2_t __attribute__((ext_vector_type(2)));
typedef __bf16 bf16x2_t __attribute__((ext_vector_type(2)));

__device__ __forceinline__ unsigned pk2(float lo, float hi) { f32x2_t v = {lo, hi}; bf16x2_t b = __builtin_convertvector(v, bf16x2_t); return __builtin_bit_cast(unsigned, b); }
__device__ __forceinline__ float bflo(unsigned w) { return __uint_as_float(w << 16); }
__device__ __forceinline__ float bfhi(unsigned w) { return __uint_as_float(w & 0xffff0000u); }
__device__ __forceinline__ int launder_tid_(int wv_s) { int ln; asm volatile("v_mbcnt_lo_u32_b32 %0, -1, 0\n\tv_mbcnt_hi_u32_b32 %0, -1, %0" : "=v"(ln)); return wv_s * 64 + ln; }
#define launder_tid() launder_tid_(wv_s)

#define SWZ_XOR(v, m) __int_as_float(__builtin_amdgcn_ds_swizzle(__float_as_int(v), (((m) << 10) | 0x1f)))
__device__ __forceinline__ float x32_sum(float v) { auto r = __builtin_amdgcn_permlane32_swap(__float_as_uint(v), __float_as_uint(v), false, false); return __uint_as_float(r[0]) + __uint_as_float(r[1]); }
__device__ __forceinline__ float x32_max(float v) { auto r = __builtin_amdgcn_permlane32_swap(__float_as_uint(v), __float_as_uint(v), false, false); return fmaxf(__uint_as_float(r[0]), __uint_as_float(r[1])); }
__device__ __forceinline__ float uni(float v) { return __uint_as_float(__builtin_amdgcn_readfirstlane(__float_as_uint(v))); }
__device__ __forceinline__ float ex2(float x) { return __builtin_amdgcn_exp2f(x); }
__device__ __forceinline__ float lg2(float x) { return __builtin_amdgcn_logf(x); }

namespace pg8 {
constexpr int BM = 256, BK = 64, HALF = 128, HTB = HALF * BK * 2, STAGE_BYTES = 8 * HTB, NXCD = 8, WGM = 4;
__host__ __device__ __forceinline__ int lds_byte(int r, int c) { const int st = (r >> 4) * 2 + (c >> 5), rr = r & 15, cc = c & 31, ob = rr * 64 + cc * 2; return st * 1024 + (ob ^ (((ob >> 9) & 1) << 5)); }
__host__ __device__ __forceinline__ void stage_rc(int b, int& R, int& C) { const int st = b / 1024, sb = b % 1024, swz = sb ^ (((sb >> 9) & 1) << 5); R = (st >> 1) * 16 + swz / 64; C = (st & 1) * 32 + (swz % 64) / 2; }
__host__ __device__ __forceinline__ int perm32(int rho) { const int n = rho >> 4, i = rho & 15; return 8 * (i >> 2) + 4 * n + (i & 3); }

struct Unit { int pm, pn; };

struct StaticOrder {
    int nM, nN, nwg, G, c;
    __device__ void init(int M, int N, int G_, int c_) { nM = M / BM; nN = N / BM; nwg = nM * nN; G = G_; c = c_; }
    __device__ bool next(int i, Unit& u) const {
        const long L = (long)i * G + c; if (L >= nwg) return false;
        int wgid = (int)L; { const int q = nwg / NXCD, r = nwg % NXCD, xcd = wgid % NXCD, off = wgid / NXCD; wgid = (xcd < r ? xcd * (q + 1) : r * (q + 1) + (xcd - r) * q) + off; }
        const int nig = WGM * nN, gid = wgid / nig, fm = gid * WGM, gsz = (nM - fm) < WGM ? (nM - fm) : WGM;
        u.pm = fm + ((wgid % nig) % gsz); u.pn = (wgid % nig) / gsz; return true;
    }
};

__device__ __forceinline__ float rstd_row4(const float* ss, int row, int fq) {
    const f32x4 a = *(const f32x4*)(ss + (size_t)row * 16 + fq * 4);
    float t = (a.x + a.y) + (a.z + a.w);
    t += SWZ_XOR(t, 16); t = x32_sum(t);
    return rsqrtf(t * (1.f / 1024.f) + 1e-6f);
}
__device__ __forceinline__ float rstd_row16(const float* ss, int row) {
    const f32x4* p = (const f32x4*)(ss + (size_t)row * 16); const f32x4 a = p[0], b = p[1], c = p[2], d = p[3];
    const float t = (((a.x + a.y) + (a.z + a.w)) + ((b.x + b.y) + (b.z + b.w))) + (((c.x + c.y) + (c.z + c.w)) + ((d.x + d.y) + (d.z + d.w)));
    return rsqrtf(t * (1.f / 1024.f) + 1e-6f);
}
struct EpiStore {
    static constexpr bool PERM = true;
    bf16_t* O; int ldc; float scale; int nsc; const float* ss; int mode;
    __device__ __forceinline__ void operator()(const f32x4 (&acc)[2][2][4][2], const Unit& u, int wr, int wc, int fr, int fq) const {
        const int row0 = u.pm * BM + wr * 64 + fr, col0 = u.pn * BM + wc * 32 + 8 * fq;
        const float sc = (u.pn < nsc) ? scale : 1.f;
        if (mode == 2) {
            const float mine = rstd_row16(ss, col0 + (fr >> 3) * HALF + (fr & 7)) * sc;
            float cs[2][8];
#pragma unroll
            for (int bj = 0; bj < 2; ++bj)
#pragma unroll
                for (int e = 0; e < 8; ++e) cs[bj][e] = __int_as_float(__builtin_amdgcn_ds_bpermute((fq * 16 + bj * 8 + e) << 2, __float_as_int(mine)));
#pragma unroll
            for (int ai = 0; ai < 2; ++ai)
#pragma unroll
                for (int m = 0; m < 4; ++m) { bf16_t* rowp = O + (size_t)(row0 + ai * HALF + m * 16) * ldc + col0;
#pragma unroll
                    for (int bj = 0; bj < 2; ++bj) { const f32x4 v0 = acc[ai][bj][m][0], v1 = acc[ai][bj][m][1];
                        u32x4 w; w.x = pk2(v0[0] * cs[bj][0], v0[1] * cs[bj][1]); w.y = pk2(v0[2] * cs[bj][2], v0[3] * cs[bj][3]); w.z = pk2(v1[0] * cs[bj][4], v1[1] * cs[bj][5]); w.w = pk2(v1[2] * cs[bj][6], v1[3] * cs[bj][7]);
                        *(u32x4*)(rowp + bj * HALF) = w; } }
        } else {
            float rsv[2][4];
#pragma unroll
            for (int ai = 0; ai < 2; ++ai)
#pragma unroll
                for (int m = 0; m < 4; ++m) { rsv[ai][m] = sc; if (mode == 1) rsv[ai][m] *= rstd_row4(ss, row0 + ai * HALF + m * 16, fq); }
#pragma unroll
            for (int ai = 0; ai < 2; ++ai)
#pragma unroll
                for (int m = 0; m < 4; ++m) { const int row = row0 + ai * HALF + m * 16; bf16_t* rowp = O + (size_t)row * ldc + col0;
                    const float rs = rsv[ai][m];
#pragma unroll
                    for (int bj = 0; bj < 2; ++bj) { const f32x4 v0 = acc[ai][bj][m][0] * rs, v1 = acc[ai][bj][m][1] * rs;
                        u32x4 w; w.x = pk2(v0[0], v0[1]); w.y = pk2(v0[2], v0[3]); w.z = pk2(v1[0], v1[1]); w.w = pk2(v1[2], v1[3]);
                        *(u32x4*)(rowp + bj * HALF) = w; } }
        }
    }
};

struct EpiLatent {
    static constexpr bool PERM = true;
    bf16_t* O; const float* gqn; const float* gqr; const float* gkn; const float2* tab32; float qscale; int pn_off;
    __device__ __forceinline__ void operator()(const f32x4 (&acc)[2][2][4][2], const Unit& u, int wr, int wc, int fr, int fq) const {
        const int row0 = u.pm * BM + wr * 64 + fr; const int tp = u.pn + pn_off;
        if (tp != 2) {
            const float* g = (tp < 2) ? gqn : gkn; const float sc = (tp < 2) ? qscale : 1.f;
            f32x4 gv[2][2];
#pragma unroll
            for (int bj = 0; bj < 2; ++bj)
#pragma unroll
                for (int n = 0; n < 2; ++n) gv[bj][n] = *(const f32x4*)(g + 32 * bj + 8 * fq + 4 * n) * sc;
#pragma unroll
            for (int ai = 0; ai < 2; ++ai)
#pragma unroll
                for (int m = 0; m < 4; ++m) { bf16_t* rowp = O + (size_t)(row0 + ai * HALF + m * 16) * 1280 + ((tp < 2) ? 96 * (4 * tp + wc) : 768 + 64 * (4 * (tp - 3) + wc)) + 8 * fq;
                    float ss = 0.f;
#pragma unroll
                    for (int bj = 0; bj < 2; ++bj)
#pragma unroll
                        for (int n = 0; n < 2; ++n) { const f32x4 v = acc[ai][bj][m][n]; ss += (v[0] * v[0] + v[1] * v[1]) + (v[2] * v[2] + v[3] * v[3]); }
                    ss += SWZ_XOR(ss, 16); ss = x32_sum(ss);
                    const float rstd = rsqrtf(ss * (1.f / 64.f) + 1e-6f);
#pragma unroll
                    for (int bj = 0; bj < 2; ++bj) { const f32x4 v0 = acc[ai][bj][m][0] * rstd * gv[bj][0], v1 = acc[ai][bj][m][1] * rstd * gv[bj][1];
                        u32x4 w; w.x = pk2(v0[0], v0[1]); w.y = pk2(v0[2], v0[3]); w.z = pk2(v1[0], v1[1]); w.w = pk2(v1[2], v1[3]);
                        *(u32x4*)(rowp + bj * 32) = w; } }
        } else {
            const int ib = 8 * (fq & 1); const bool up = (fq >= 2);
            f32x4 gv[2];
#pragma unroll
            for (int n = 0; n < 2; ++n) gv[n] = *(const f32x4*)(gqr + 8 * fq + 4 * n);
#pragma unroll
            for (int ai = 0; ai < 2; ++ai)
#pragma unroll
                for (int m = 0; m < 4; ++m) { const int row = row0 + ai * HALF + m * 16; bf16_t* rowp = O + (size_t)row * 1280 + 96 * wc + 64 + 8 * fq;
                    const f32x4* tp = (const f32x4*)(tab32 + (size_t)(row & (2048 - 1)) * 16 + ib);
                    const f32x4 t0 = tp[0], t1 = tp[1], t2 = tp[2], t3 = tp[3];
                    const float cs[8] = {t0.x, t0.z, t1.x, t1.z, t2.x, t2.z, t3.x, t3.z}, sn[8] = {t0.y, t0.w, t1.y, t1.w, t2.y, t2.w, t3.y, t3.w};
#pragma unroll
                    for (int bj = 0; bj < 2; ++bj) {
                        const f32x4 a0 = acc[ai][bj][m][0], a1 = acc[ai][bj][m][1];
                        float ss = (a0[0] * a0[0] + a0[1] * a0[1]) + (a0[2] * a0[2] + a0[3] * a0[3]) + (a1[0] * a1[0] + a1[1] * a1[1]) + (a1[2] * a1[2] + a1[3] * a1[3]);
                        ss += SWZ_XOR(ss, 16); ss = x32_sum(ss);
                        const float rstd = rsqrtf(ss * (1.f / 32.f) + 1e-6f) * qscale;
                        float y[8], o[8];
#pragma unroll
                        for (int e = 0; e < 4; ++e) { y[e] = a0[e] * rstd * gv[0][e]; y[4 + e] = a1[e] * rstd * gv[1][e]; }
#pragma unroll
                        for (int e = 0; e < 8; ++e) { auto r = __builtin_amdgcn_permlane32_swap(__float_as_uint(y[e]), __float_as_uint(y[e]), false, false);
                            const float y1 = __uint_as_float(r[0]), y2 = __uint_as_float(r[1]);
                            o[e] = up ? (y2 * cs[e] + y1 * sn[e]) : (y1 * cs[e] - y2 * sn[e]); }
                        u32x4 w; w.x = pk2(o[0], o[1]); w.y = pk2(o[2], o[3]); w.z = pk2(o[4], o[5]); w.w = pk2(o[6], o[7]);
                        *(u32x4*)(rowp + bj * 384) = w; } }
        }
    }
};
__device__ __forceinline__ float silu_mul(float g, float u) { return g * __builtin_amdgcn_rcpf(1.f + ex2(-1.4426950408889634f * g)) * u; }
struct EpiSwiglu {
    static constexpr bool PERM = true;
    bf16_t* O; int ldc; const float* ss;
    __device__ __forceinline__ void operator()(const f32x4 (&acc)[2][2][4][2], const Unit& u, int wr, int wc, int fr, int fq) const {
        const int row0 = u.pm * BM + wr * 64 + fr, col0 = u.pn * HALF + wc * 32 + 8 * fq;
        float rsv[2][4];
#pragma unroll
        for (int ai = 0; ai < 2; ++ai)
#pragma unroll
            for (int m = 0; m < 4; ++m) rsv[ai][m] = rstd_row4(ss, row0 + ai * HALF + m * 16, fq);
#pragma unroll
        for (int ai = 0; ai < 2; ++ai)
#pragma unroll
            for (int m = 0; m < 4; ++m) { const int row = row0 + ai * HALF + m * 16; bf16_t* rowp = O + (size_t)row * ldc + col0; const float rs = rsv[ai][m];
                const f32x4 g0 = acc[ai][0][m][0] * rs, g1 = acc[ai][0][m][1] * rs, u0 = acc[ai][1][m][0] * rs, u1 = acc[ai][1][m][1] * rs;
                u32x4 w; w.x = pk2(silu_mul(g0[0], u0[0]), silu_mul(g0[1], u0[1])); w.y = pk2(silu_mul(g0[2], u0[2]), silu_mul(g0[3], u0[3]));
                w.z = pk2(silu_mul(g1[0], u1[0]), silu_mul(g1[1], u1[1])); w.w = pk2(silu_mul(g1[2], u1[2]), silu_mul(g1[3], u1[3]));
                *(u32x4*)rowp = w; }
    }
};
struct EpiResid {
    static constexpr bool PERM = false;
    float* out; int ldc; bf16_t* xb; float* ss;
    __device__ __forceinline__ void operator()(const f32x4 (&acc)[2][2][4][2], const Unit& u, int wr, int wc, int fr, int fq) const {
        const int row0 = u.pm * BM + wr * 64 + fr, col0 = u.pn * BM + wc * 32 + 4 * fq;
#pragma unroll
        for (int ai = 0; ai < 2; ++ai) {
            u32x2 bv[4][2][2];
#pragma unroll
            for (int m = 0; m < 4; ++m)
#pragma unroll
                for (int bj = 0; bj < 2; ++bj)
#pragma unroll
                    for (int n = 0; n < 2; ++n) bv[m][bj][n] = *(const u32x2*)(xb + (size_t)(row0 + ai * HALF + m * 16) * ldc + col0 + bj * HALF + n * 16);
            asm volatile("" ::: "memory");
#pragma unroll
            for (int m = 0; m < 4; ++m) { const int row = row0 + ai * HALF + m * 16; const size_t off = (size_t)row * ldc + col0; float sq = 0.f;
#pragma unroll
                for (int bj = 0; bj < 2; ++bj)
#pragma unroll
                    for (int n = 0; n < 2; ++n) { const size_t p = off + bj * HALF + n * 16; const u32x2 b = bv[m][bj][n];
                        f32x4 v = acc[ai][bj][m][n]; v[0] += bflo(b.x); v[1] += bfhi(b.x); v[2] += bflo(b.y); v[3] += bfhi(b.y);
                        if (out) { *(f32x4*)(out + p) = v; }
                        else { sq += (v[0] * v[0] + v[1] * v[1]) + (v[2] * v[2] + v[3] * v[3]);
                               u32x2 w; w.x = pk2(v[0], v[1]); w.y = pk2(v[2], v[3]); *(u32x2*)(xb + p) = w; } }
                if (!out) { sq += SWZ_XOR(sq, 16); sq = x32_sum(sq);
                            if (fq == 0) ss[(size_t)row * 16 + u.pn * 4 + wc] = sq; } }
            asm volatile("" ::: "memory");
        }
    }
};

template <class Epi, int K, int LDA, int LDB>
__device__ __forceinline__ void gemm_phase(LAS unsigned char* lds, const bf16_t* gA, const bf16_t* gBt, const StaticOrder& S, const Epi& E, int wv_s) {
    const int tid = launder_tid(), wid = __builtin_amdgcn_readfirstlane(tid >> 6), lane = tid & 63, wr = wid >> 2, wc = wid & 3, fr = lane & 15, fq = lane >> 4;
    int nt = K / BK; asm volatile("" : "+s"(nt));
    unsigned voffA[2], voffB[2];
#pragma unroll
    for (int i = 0; i < 2; ++i) { int R, C; stage_rc(tid * 16 + i * 8192, R, C); const int Rb = Epi::PERM ? ((R & ~31) + perm32(R & 31)) : R;
        voffA[i] = (unsigned)(R * LDA + C) * 2u; voffB[i] = (unsigned)(Rb * LDB + C) * 2u; }
    constexpr size_t kstep = (size_t)(BK * 2);
    constexpr size_t hsA = (size_t)HALF * LDA * 2, hsB = (size_t)HALF * LDB * 2;
    constexpr size_t tsA = 2 * hsA, tsB = 2 * hsB;
    const unsigned ldsw = (unsigned)wid * 1024u;
    const int aoff = lds_byte(wr * 64 + fr, fq * 8), boff = lds_byte(wc * 32 + fr, fq * 8);
#define PG8_SA(b, h) (((b) * 2 + (h)) * HTB)
#define PG8_SB(b, h) ((4 + (b) * 2 + (h)) * HTB)
#define PG8_STAGE(bufoff, gbase, voff) do { _Pragma("unroll") for (int _i = 0; _i < 2; ++_i) \
        __builtin_amdgcn_global_load_lds((const unsigned*)((const char*)(gbase) + (voff)[_i]), (LAS unsigned*)(lds + (bufoff) + ldsw + _i * 8192), 16, 0, 0); } while (0)
#define PG8_LDA(dst, b, h) do { _Pragma("unroll") for (int m = 0; m < 4; ++m) _Pragma("unroll") for (int k = 0; k < 2; ++k) dst[m][k] = *(const LAS bf16x8*)(lds + PG8_SA(b, h) + aoff + m * 2048 + k * 1024); } while (0)
#define PG8_LDB(dst, b, h) do { _Pragma("unroll") for (int n = 0; n < 2; ++n) _Pragma("unroll") for (int k = 0; k < 2; ++k) dst[n][k] = *(const LAS bf16x8*)(lds + PG8_SB(b, h) + boff + n * 2048 + k * 1024); } while (0)
#define PG8_MMA(ai, bj, At, Bt) do { __builtin_amdgcn_s_setprio(1); _Pragma("unroll") for (int m = 0; m < 4; ++m) _Pragma("unroll") for (int n = 0; n < 2; ++n) _Pragma("unroll") for (int k = 0; k < 2; ++k) \
        acc[ai][bj][m][n] = __builtin_amdgcn_mfma_f32_16x16x32_bf16(Bt[n][k], At[m][k], acc[ai][bj][m][n], 0, 0, 0); __builtin_amdgcn_s_setprio(0); } while (0)
#define PG8_WAIT_V(n) asm volatile("s_waitcnt vmcnt(" #n ")" ::: "memory")
#define PG8_WAIT_L(n) asm volatile("s_waitcnt lgkmcnt(" #n ")" ::: "memory")
#define PG8_BAR __builtin_amdgcn_s_barrier()
#define PG8_SCHED __builtin_amdgcn_sched_barrier(0)
    Unit cur, nxt; int ui = 0;
    if (!S.next(0, cur)) return;
    f32x4 acc[2][2][4][2];
#pragma unroll
    for (int a = 0; a < 2; ++a)
#pragma unroll
        for (int b = 0; b < 2; ++b)
#pragma unroll
            for (int m = 0; m < 4; ++m)
#pragma unroll
                for (int n = 0; n < 2; ++n) acc[a][b][m][n] = (f32x4){0.f, 0.f, 0.f, 0.f};
    bf16x8 At[4][2], B0[2][2], B1[2][2];
    const char* cA = (const char*)gA + (size_t)cur.pm * tsA; const char* cB = (const char*)gBt + (size_t)cur.pn * tsB;
    PG8_STAGE(PG8_SB(0, 0), cB, voffB); PG8_STAGE(PG8_SB(0, 1), cB + hsB, voffB); PG8_STAGE(PG8_SA(0, 0), cA, voffA); PG8_STAGE(PG8_SA(0, 1), cA + hsA, voffA);
    if (wr == 1) PG8_BAR;
    PG8_WAIT_V(2); PG8_BAR;
    PG8_STAGE(PG8_SB(1, 0), cB + kstep, voffB); PG8_STAGE(PG8_SA(1, 0), cA + kstep, voffA); PG8_STAGE(PG8_SB(1, 1), cB + hsB + kstep, voffB);
    PG8_WAIT_V(6); PG8_BAR;
    for (;;) {
        const bool has_next = S.next(ui + 1, nxt);
        const char* nA = has_next ? (const char*)gA + (size_t)nxt.pm * tsA : cA; const char* nB = has_next ? (const char*)gBt + (size_t)nxt.pn * tsB : cB;
#pragma nounroll
        for (int t = 0; t < nt; t += 2) {
            const bool last = (t == nt - 2);
            const char* a1 = cA + (size_t)(t + 1) * kstep;
            const char* a2 = last ? nA : cA + (size_t)(t + 2) * kstep; const char* b2 = last ? nB : cB + (size_t)(t + 2) * kstep;
            const char* a3 = a2 + kstep; const char* b3 = b2 + kstep;
            PG8_LDB(B0, 0, 0); PG8_LDB(B1, 0, 1); PG8_SCHED; PG8_LDA(At, 0, 0); PG8_STAGE(PG8_SA(1, 1), a1 + hsA, voffA);
            PG8_WAIT_V(8); PG8_WAIT_L(0); PG8_BAR; PG8_MMA(0, 0, At, B0); PG8_MMA(0, 1, At, B1); PG8_BAR; PG8_SCHED;
            PG8_LDA(At, 0, 1); PG8_STAGE(PG8_SB(0, 0), b2, voffB); PG8_STAGE(PG8_SB(0, 1), b2 + hsB, voffB); PG8_STAGE(PG8_SA(0, 0), a2, voffA);
            PG8_WAIT_V(8); PG8_WAIT_L(0); PG8_BAR; PG8_MMA(1, 0, At, B0); PG8_MMA(1, 1, At, B1); PG8_BAR; PG8_SCHED;
            PG8_LDB(B0, 1, 0); PG8_LDB(B1, 1, 1); PG8_SCHED; PG8_LDA(At, 1, 0); PG8_STAGE(PG8_SA(0, 1), a2 + hsA, voffA);
            PG8_WAIT_V(8); PG8_WAIT_L(0); PG8_BAR; PG8_MMA(0, 0, At, B0); PG8_MMA(0, 1, At, B1); PG8_BAR; PG8_SCHED;
            PG8_LDA(At, 1, 1); PG8_STAGE(PG8_SB(1, 0), b3, voffB); PG8_STAGE(PG8_SB(1, 1), b3 + hsB, voffB); PG8_STAGE(PG8_SA(1, 0), a3, voffA);
            PG8_WAIT_V(8); PG8_WAIT_L(0); PG8_BAR; PG8_MMA(1, 0, At, B0); PG8_MMA(1, 1, At, B1); PG8_BAR; PG8_SCHED;
        }
        if (wr == 0) PG8_BAR;
        E(acc, cur, wr, wc, fr, fq);
        if (!has_next) break;
#pragma unroll
        for (int a = 0; a < 2; ++a)
#pragma unroll
            for (int b = 0; b < 2; ++b)
#pragma unroll
                for (int m = 0; m < 4; ++m)
#pragma unroll
                    for (int n = 0; n < 2; ++n) acc[a][b][m][n] = (f32x4){0.f, 0.f, 0.f, 0.f};
        cur = nxt; cA = nA; cB = nB; ++ui;
        if (wr == 1) PG8_BAR;
    }
    PG8_WAIT_V(0);
    PG8_BAR;
#undef PG8_SA
#undef PG8_SB
#undef PG8_STAGE
#undef PG8_LDA
#undef PG8_LDB
#undef PG8_MMA
#undef PG8_WAIT_V
#undef PG8_WAIT_L
#undef PG8_BAR
#undef PG8_SCHED
}
}

constexpr int NB = 16, SEQ = 2048, DM = 1024, MT = NB * SEQ, DFF = 2816;
constexpr float EPS = 1e-6f;
constexpr float LOG2E = 1.4426950408889634f;
constexpr size_t MiB = 1u << 20;
constexpr size_t WS_EVEN = 0, EVEN_STRIDE = 8 * MiB;
constexpr size_t WS_ODD = 16 * MiB, ODD_STRIDE = 8 * MiB;
constexpr size_t WS_FFN = 32 * MiB, FFN_STRIDE = 17 * MiB;
constexpr size_t WS_ROPE = 100 * MiB;
constexpr size_t WS_XB = 102 * MiB, WS_MIX = 166 * MiB, WS_R = 230 * MiB;
constexpr size_t WS_P = WS_R, WS_VTA = WS_R + 96 * MiB, WS_QB = WS_R + 128 * MiB, WS_VTB = WS_R + 208 * MiB;
constexpr size_t WS_QK = WS_R, WS_VTC = WS_R + 128 * MiB, WS_ACT = WS_R, WS_CTL = 470 * MiB, CTL_BYTES = 16384, WS_SS = 471 * MiB, WS_END = 473 * MiB;
constexpr int LDS_BYTES = 131072 + 128;
#ifndef ATT_REP
#define ATT_REP 1
#endif
#ifndef ATT_REP_O
#define ATT_REP_O 1
#endif
#ifndef GU_REP
#define GU_REP 1
#endif
#ifndef EW_REP
#define EW_REP 1
#endif
#ifndef SYNC_REP
#define SYNC_REP 1
#endif

struct Args { const float* in[22]; float* out; unsigned char* ws; };
typedef const __attribute__((address_space(4))) Args* KA;
__device__ __forceinline__ KA ka_get() { KA p = (KA)__builtin_amdgcn_kernarg_segment_ptr(); asm volatile("" : "+s"(p)); return p; }

__device__ __forceinline__ float wave_sum(float v) {
    v += SWZ_XOR(v, 1); v += SWZ_XOR(v, 2); v += SWZ_XOR(v, 4); v += SWZ_XOR(v, 8); v += SWZ_XOR(v, 16);
    return x32_sum(v);
}

struct PJ { const float* W; int K, ld, c0, ncols, grp, sgrp, dgrp; bf16_t* WT; int row_off; const float* gain; int ldd, kofs, mode; };
__device__ __forceinline__ PJ get_job(int j, KA a) {
    PJ p; unsigned char* ws = a->ws;
    p.grp = 1 << 20; p.sgrp = 0; p.dgrp = 0; p.c0 = 0; p.row_off = 0; p.gain = nullptr; p.ldd = 0; p.kofs = 0; p.mode = 0;
    if (j < 16) {
        const int i = j / 8, s = j % 8; unsigned char* wb = ws + WS_EVEN + i * EVEN_STRIDE; const float* win = a->in[3] + (size_t)i * 1024 * 1952; const float* gm = a->in[1] + (size_t)(2 * i) * 1024;
        if (s == 0) { p.W = win; p.K = 1024; p.ld = 1952; p.c0 = 0; p.ncols = 1024; p.WT = (bf16_t*)wb; p.row_off = 0; p.gain = gm; }
        else if (s == 1) { p.W = win; p.K = 1024; p.ld = 1952; p.c0 = 1024; p.ncols = 512; p.WT = (bf16_t*)(wb + 3 * MiB); p.gain = gm; }
        else if (s == 2) { p.W = win; p.K = 1024; p.ld = 1952; p.c0 = 1536; p.ncols = 416; p.WT = (bf16_t*)wb; p.row_off = 1024; p.gain = gm; }
        else if (s == 3) { p.W = a->in[9] + (size_t)i * 256 * 768; p.K = 256; p.ld = 768; p.ncols = 512; p.WT = (bf16_t*)(wb + 6 * MiB); p.ldd = 384; p.mode = 1; }
        else if (s == 7) { p.W = a->in[9] + (size_t)i * 256 * 768; p.K = 256; p.ld = 768; p.ncols = 256; p.WT = (bf16_t*)(wb + 6 * MiB); p.ldd = 384; p.mode = 2; }
        else if (s == 4) { p.W = a->in[11] + (size_t)i * 128 * 1024; p.K = 128; p.ld = 1024; p.c0 = 0; p.ncols = 512; p.WT = (bf16_t*)(wb + 6 * MiB); p.ldd = 384; p.kofs = 256; p.mode = 3; }
        else if (s == 5) { p.W = a->in[11] + (size_t)i * 128 * 1024; p.K = 128; p.ld = 1024; p.c0 = 64; p.ncols = 512; p.grp = 64; p.sgrp = 128; p.dgrp = 64; p.WT = (bf16_t*)(wb + 6 * MiB + 960 * 1024); p.ldd = 384; p.kofs = 256; }
        else { p.W = a->in[16] + (size_t)i * 1024 * 1024; p.K = 1024; p.ld = 1024; p.ncols = 1024; p.WT = (bf16_t*)(wb + 4 * MiB); }
    } else if (j < 22) {
        const int i = (j - 16) / 3, s = (j - 16) % 3; unsigned char* wb = ws + WS_ODD + i * ODD_STRIDE; const float* gm = a->in[1] + (size_t)(2 * i + 1) * 1024;
        if (s == 0) { p.W = a->in[17] + (size_t)i * 1024 * 3072; p.K = 1024; p.ld = 3072; p.c0 = 0; p.ncols = 2048; p.WT = (bf16_t*)wb; p.gain = gm; }
        else if (s == 1) { p.W = a->in[17] + (size_t)i * 1024 * 3072; p.K = 1024; p.ld = 3072; p.c0 = 2048; p.ncols = 1024; p.WT = (bf16_t*)(wb + 4 * MiB); p.gain = gm; }
        else { p.W = a->in[18] + (size_t)i * 1024 * 1024; p.K = 1024; p.ld = 1024; p.ncols = 1024; p.WT = (bf16_t*)(wb + 6 * MiB); }
    } else {
        const int l = (j - 22) / 3, s = (j - 22) % 3; unsigned char* wb = ws + WS_FFN + l * FFN_STRIDE; const float* gf = a->in[2] + (size_t)l * 1024;
        if (s == 0) { p.W = a->in[19] + (size_t)l * 1024 * DFF; p.K = 1024; p.ld = DFF; p.ncols = DFF; p.grp = 128; p.sgrp = 128; p.dgrp = 256; p.WT = (bf16_t*)wb; p.row_off = 0; p.gain = gf; }
        else if (s == 1) { p.W = a->in[20] + (size_t)l * 1024 * DFF; p.K = 1024; p.ld = DFF; p.ncols = DFF; p.grp = 128; p.sgrp = 128; p.dgrp = 256; p.WT = (bf16_t*)wb; p.row_off = 128; p.gain = gf; }
        else { p.W = a->in[21] + (size_t)l * DFF * 1024; p.K = DFF; p.ld = 1024; p.ncols = 1024; p.WT = (bf16_t*)(wb + 11 * MiB); }
    }
    return p;
}
constexpr int NJOBS = 34;

__device__ __forceinline__ void prep_phase(KA a, LAS unsigned char* lds, int NGW, int wv_s) {
    const int tid = launder_tid(), lane = tid & 63, wave = __builtin_amdgcn_readfirstlane(tid >> 6), gw = blockIdx.x * 8 + wave;
    LAS float* scr = (LAS float*)(lds + wave * 8448);
    int rot = 0;
    for (int j = 0; j < NJOBS; ++j) {
        PJ p = get_job(j, a); if (p.ldd == 0) p.ldd = p.K;
        const int nblk = p.ncols / 32, nitems = (p.K / 64) * nblk;
        int start = gw - rot; if (start < 0) start += NGW;
        for (int it = start; it < nitems; it += NGW) {
            const int kb = it / nblk, nb = it % nblk, k0 = 64 * kb, nn0 = 32 * nb;
            const int q = nn0 / p.grp, r = nn0 % p.grp;
            int sc = p.c0 + q * p.sgrp + r, dr = p.row_off + q * p.dgrp + r;
            if (p.mode == 1) { const int hh = nb >> 1, hf = nb & 1; sc = 96 * hh + 32 * hf; dr = 256 * (hh >> 2) + 128 * hf + 32 * (hh & 3); }
            else if (p.mode == 2) { sc = 96 * nb + 64; dr = 512 + 128 * (nb >> 2) + 32 * (nb & 3); }
            else if (p.mode == 3) { const int hh = nb >> 1, hf = nb & 1; sc = 128 * hh + 32 * hf; dr = 768 + 256 * (hh >> 2) + 128 * hf + 32 * (hh & 3); }
            float wv[32], gv[32];
#pragma unroll
            for (int i = 0; i < 32; ++i) { const int kk = 2 * i + (lane >> 5); wv[i] = __builtin_nontemporal_load(&p.W[(size_t)(k0 + kk) * p.ld + sc + (lane & 31)]);       gv[i] = p.gain ? p.gain[k0 + kk] : 1.f; }
#pragma unroll
            for (int i = 0; i < 32; ++i) { const int kk = 2 * i + (lane >> 5); scr[kk * 33 + (lane & 31)] = wv[i] * gv[i]; }
            asm volatile("s_waitcnt lgkmcnt(0)" ::: "memory");
            const int c = lane & 7;
#pragma unroll
            for (int jj = 0; jj < 4; ++jj) { const int n = (lane >> 3) + 8 * jj; const LAS float* s = scr + (8 * c) * 33 + n;
                u32x4 o; o.x = pk2(s[0 * 33], s[1 * 33]); o.y = pk2(s[2 * 33], s[3 * 33]); o.z = pk2(s[4 * 33], s[5 * 33]); o.w = pk2(s[6 * 33], s[7 * 33]);
                *(u32x4*)(p.WT + (size_t)(dr + n) * p.ldd + p.kofs + k0 + 8 * c) = o; }
            asm volatile("s_waitcnt lgkmcnt(0)" ::: "memory");
        }
        rot = (rot + nitems) % NGW;
    }
    float2* tab64 = (float2*)(a->ws + WS_ROPE); float2* tab32 = (float2*)(a->ws + WS_ROPE + 512 * 1024);
    const int gt = gw * 64 + lane, NT = NGW * 64;
    for (int e = gt; e < SEQ * 48; e += NT) {
        const int pos = e / 48, r = e % 48; const int half = r < 32 ? 32 : 16, i = r < 32 ? r : r - 32;
        const float inv = ex2(-((float)i / (float)half) * 13.287712379549449f);
        const float ang = (float)pos * inv;
        const float k = rintf(ang * 0.15915494309189535f);
        float rr = fmaf(-k, 6.2831854820251465f, ang); rr = fmaf(-k, -1.7484555e-07f, rr);
        const float2 cs = make_float2(__cosf(rr), __sinf(rr));
        if (r < 32) tab64[pos * 32 + i] = cs; else tab32[pos * 16 + i] = cs;
    }
}

__device__ __forceinline__ void norm_phase(const float* x, bf16_t* xb, float* ss, int NGW, int wv_s) {
    const int tid = launder_tid(), lane = tid & 63, gw = blockIdx.x * 8 + __builtin_amdgcn_readfirstlane(tid >> 6);
    for (int m0 = gw * 4; m0 < MT; m0 += NGW * 4) {
        f32x4 v[4][4];
#pragma unroll
        for (int r = 0; r < 4; ++r) { const f32x4* xr = (const f32x4*)(x + (size_t)(m0 + r) * DM) + lane;
#pragma unroll
            for (int j = 0; j < 4; ++j) v[r][j] = __builtin_nontemporal_load(xr + 64 * j); }
#pragma unroll
        for (int r = 0; r < 4; ++r) { const int m = m0 + r; float s = 0.f;
#pragma unroll
            for (int j = 0; j < 4; ++j) s += (v[r][j].x * v[r][j].x + v[r][j].y * v[r][j].y) + (v[r][j].z * v[r][j].z + v[r][j].w * v[r][j].w);
            const float tot = wave_sum(s);
            u32x2* o8 = (u32x2*)(xb + (size_t)m * DM) + lane;
#pragma unroll
            for (int j = 0; j < 4; ++j) { u32x2 w; w.x = pk2(v[r][j].x, v[r][j].y); w.y = pk2(v[r][j].z, v[r][j].w); o8[64 * j] = w; }
            if (lane < 16) ss[(size_t)m * 16 + lane] = (lane == 0) ? tot : 0.f; }
    }
}

__device__ __forceinline__ void unpack8(const u32x4 w, float (&f)[8]) { f[0] = bflo(w.x); f[1] = bfhi(w.x); f[2] = bflo(w.y); f[3] = bfhi(w.y); f[4] = bflo(w.z); f[5] = bfhi(w.z); f[6] = bflo(w.w); f[7] = bfhi(w.w); }
__device__ __forceinline__ u32x4 pack8(const float (&f)[8]) { u32x4 w; w.x = pk2(f[0], f[1]); w.y = pk2(f[2], f[3]); w.z = pk2(f[4], f[5]); w.w = pk2(f[6], f[7]); return w; }

constexpr int PNT = 4;
__device__ __forceinline__ void post_e2(KA a, int i, int NGW, int wv_s) {
    const int tid = launder_tid(), lane = tid & 63, gw = blockIdx.x * 8 + __builtin_amdgcn_readfirstlane(tid >> 6);
    bf16_t* P = (bf16_t*)(a->ws + WS_P);
    const float2* tab64 = (const float2*)(a->ws + WS_ROPE); const float2* tab32 = (const float2*)(a->ws + WS_ROPE + 512 * 1024);
    const float* gq = a->in[4] + i * 64; const float* gk = a->in[5] + i * 64;
    const float* gql = a->in[8] + i * 256; const float* gkv = a->in[10] + i * 128; const float* gkr = a->in[15] + i * 32;
    const int gI = lane >> 2, sub = lane & 3, e0 = sub * 8;
    const float* gn = (gI < 8) ? gq : gk;
    float g1[8], g2[8];
#pragma unroll
    for (int j = 0; j < 8; ++j) { g1[j] = gn[e0 + j]; g2[j] = gn[32 + e0 + j]; }
    const float qs = (gI < 8) ? 0.125f * LOG2E : 1.f;
    const f32x4 gql4 = *(const f32x4*)(gql + 4 * lane);
    const float gkv0 = gkv[2 * lane], gkv1 = gkv[2 * lane + 1];
    const int ii = lane & 15;
    const float gkr0 = gkr[ii], gkr1 = gkr[ii + 16];
    for (int m0 = gw * PNT; m0 < MT; m0 += NGW * PNT) {
        u32x4 A1[PNT], A2[PNT]; u32x2 Bq[PNT]; unsigned Ckv[PNT]; unsigned short D1[PNT], D2[PNT]; float2 T32[PNT];
#pragma unroll
        for (int t = 0; t < PNT; ++t) { bf16_t* row = P + (size_t)(m0 + t) * 1536; const int pos = (m0 + t) & (SEQ - 1);
            A1[t] = *(const u32x4*)(row + gI * 64 + e0); A2[t] = *(const u32x4*)(row + gI * 64 + e0 + 32);
            Bq[t] = *(const u32x2*)(row + 1024 + 4 * lane); Ckv[t] = *((const unsigned*)(row + 1280) + lane);
            D1[t] = row[1408 + ii]; D2[t] = row[1408 + 16 + ii]; T32[t] = tab32[pos * 16 + ii]; }
#pragma unroll
        for (int t = 0; t < PNT; ++t) {
            bf16_t* row = P + (size_t)(m0 + t) * 1536; const int pos = (m0 + t) & (SEQ - 1);
            {
                float x1[8], x2[8]; unpack8(A1[t], x1); unpack8(A2[t], x2);
                float ss = 0.f;
#pragma unroll
                for (int j = 0; j < 8; ++j) ss += x1[j] * x1[j] + x2[j] * x2[j];
                ss += SWZ_XOR(ss, 1); ss += SWZ_XOR(ss, 2);
                const float rstd = rsqrtf(ss * (1.f / 64.f) + EPS);
                float o1[8], o2[8];
                const f32x4* tp = (const f32x4*)(tab64 + pos * 32 + e0);
#pragma unroll
                for (int j2 = 0; j2 < 4; ++j2) { const f32x4 cs = tp[j2];
                    { const int j = 2 * j2; const float y1 = x1[j] * rstd * g1[j], y2 = x2[j] * rstd * g2[j]; o1[j] = (y1 * cs.x - y2 * cs.y) * qs; o2[j] = (y2 * cs.x + y1 * cs.y) * qs; }
                    { const int j = 2 * j2 + 1; const float y1 = x1[j] * rstd * g1[j], y2 = x2[j] * rstd * g2[j]; o1[j] = (y1 * cs.z - y2 * cs.w) * qs; o2[j] = (y2 * cs.z + y1 * cs.w) * qs; } }
                *(u32x4*)(row + gI * 64 + e0) = pack8(o1); *(u32x4*)(row + gI * 64 + e0 + 32) = pack8(o2);
            }
            {
                const u32x2 w = Bq[t];
                const float x0 = bflo(w.x), x1 = bfhi(w.x), x2 = bflo(w.y), x3 = bfhi(w.y);
                const float rstd = rsqrtf(wave_sum(x0 * x0 + x1 * x1 + x2 * x2 + x3 * x3) * (1.f / 256.f) + EPS);
                u32x2 o; o.x = pk2(x0 * rstd * gql4.x, x1 * rstd * gql4.y); o.y = pk2(x2 * rstd * gql4.z, x3 * rstd * gql4.w); *(u32x2*)(row + 1024 + 4 * lane) = o;
            }
            {
                const unsigned w = Ckv[t]; const float x0 = bflo(w), x1 = bfhi(w);
                const float rstd = rsqrtf(wave_sum(x0 * x0 + x1 * x1) * (1.f / 128.f) + EPS);
                *((unsigned*)(row + 1280) + lane) = pk2(x0 * rstd * gkv0, x1 * rstd * gkv1);
            }
            {
                const float x1 = __uint_as_float((unsigned)D1[t] << 16), x2 = __uint_as_float((unsigned)D2[t] << 16);
                float ss = x1 * x1 + x2 * x2;
                ss += SWZ_XOR(ss, 1); ss += SWZ_XOR(ss, 2); ss += SWZ_XOR(ss, 4); ss += SWZ_XOR(ss, 8);
                const float rstd = rsqrtf(ss * (1.f / 32.f) + EPS);
                const float2 cs = T32[t]; const float y1 = x1 * rstd * gkr0, y2 = x2 * rstd * gkr1;
                const unsigned r1 = pk2(y1 * cs.x - y2 * cs.y, 0.f), r2 = pk2(y2 * cs.x + y1 * cs.y, 0.f);
                if (lane < 16) { row[1408 + ii] = (bf16_t)(r1 & 0xffffu); row[1408 + 16 + ii] = (bf16_t)(r2 & 0xffffu); }
            }
        }
    }
}

__device__ __forceinline__ void post_e4(KA a, int i, int NGW, int wv_s) {
    const int tid = launder_tid(), lane = tid & 63, gw = blockIdx.x * 8 + __builtin_amdgcn_readfirstlane(tid >> 6);
    bf16_t* QB = (bf16_t*)(a->ws + WS_QB);
    const float2* tab32 = (const float2*)(a->ws + WS_ROPE + 512 * 1024);
    const float* gqn = a->in[12] + i * 64; const float* gqr = a->in[13] + i * 32; const float* gkn = a->in[14] + i * 64;
    const int h = lane >> 3, sub = lane & 7;
    float gq8[8], gk8[8];
#pragma unroll
    for (int j = 0; j < 8; ++j) { gq8[j] = gqn[sub * 8 + j]; gk8[j] = gkn[sub * 8 + j]; }
    const float gr0 = gqr[2 * sub], gr1 = gqr[2 * sub + 1], gr2 = gqr[16 + 2 * sub], gr3 = gqr[16 + 2 * sub + 1];
    const float CB = 0.10206207261596575f * LOG2E;
    for (int m0 = gw * PNT; m0 < MT; m0 += NGW * PNT) {
        u32x4 QN[PNT], KNv[PNT]; unsigned W1[PNT], W2[PNT]; f32x4 TC[PNT];
#pragma unroll
        for (int t = 0; t < PNT; ++t) { bf16_t* row = QB + (size_t)(m0 + t) * 1280; const int pos = (m0 + t) & (SEQ - 1);
            QN[t] = *(const u32x4*)(row + h * 96 + sub * 8); KNv[t] = *(const u32x4*)(row + 768 + h * 64 + sub * 8);
            const unsigned* p = (const unsigned*)(row + h * 96 + 64) + sub; W1[t] = p[0]; W2[t] = p[8];
            TC[t] = *(const f32x4*)(tab32 + pos * 16 + 2 * sub); }
#pragma unroll
        for (int t = 0; t < PNT; ++t) {
            bf16_t* row = QB + (size_t)(m0 + t) * 1280;
            {
                float x[8]; unpack8(QN[t], x);
                float ss = 0.f;
#pragma unroll
                for (int j = 0; j < 8; ++j) ss += x[j] * x[j];
                ss += SWZ_XOR(ss, 1); ss += SWZ_XOR(ss, 2); ss += SWZ_XOR(ss, 4);
                const float rstd = rsqrtf(ss * (1.f / 64.f) + EPS) * CB;
#pragma unroll
                for (int j = 0; j < 8; ++j) x[j] = x[j] * rstd * gq8[j];
                *(u32x4*)(row + h * 96 + sub * 8) = pack8(x);
            }
            {
                unsigned* p = (unsigned*)(row + h * 96 + 64) + sub; const unsigned w1 = W1[t], w2 = W2[t];
                const float a0 = bflo(w1), a1 = bfhi(w1), b0 = bflo(w2), b1 = bfhi(w2);
                float ss = a0 * a0 + a1 * a1 + b0 * b0 + b1 * b1;
                ss += SWZ_XOR(ss, 1); ss += SWZ_XOR(ss, 2); ss += SWZ_XOR(ss, 4);
                const float rstd = rsqrtf(ss * (1.f / 32.f) + EPS);
                const f32x4 c = TC[t];
                const float ya0 = a0 * rstd * gr0, ya1 = a1 * rstd * gr1, yb0 = b0 * rstd * gr2, yb1 = b1 * rstd * gr3;
                p[0] = pk2((ya0 * c.x - yb0 * c.y) * CB, (ya1 * c.z - yb1 * c.w) * CB);
                p[8] = pk2((yb0 * c.x + ya0 * c.y) * CB, (yb1 * c.z + ya1 * c.w) * CB);
            }
            {
                float x[8]; unpack8(KNv[t], x);
                float ss = 0.f;
#pragma unroll
                for (int j = 0; j < 8; ++j) ss += x[j] * x[j];
                ss += SWZ_XOR(ss, 1); ss += SWZ_XOR(ss, 2); ss += SWZ_XOR(ss, 4);
                const float rstd = rsqrtf(ss * (1.f / 64.f) + EPS);
#pragma unroll
                for (int j = 0; j < 8; ++j) x[j] = x[j] * rstd * gk8[j];
                *(u32x4*)(row + 768 + h * 64 + sub * 8) = pack8(x);
            }
        }
    }
}

template <int DK, int DV> struct AttnGeo {
    static constexpr int KS = DK * 2 + 16, KBYTES = 64 * KS, VS = 136, VBYTES = DV * VS;
    static constexpr int KOFF = 0, VOFF = 2 * KBYTES;
};
template <int DK> __device__ __forceinline__ int kchunk_off(int dc) { return 8 * dc; }
template <int DK, int DV>
__device__ __forceinline__ void stage_load(int tid, int j, const bf16_t* K1, int ldk1, const bf16_t* K2, int ldk2, const bf16_t* Vt, u32x4& kr0, u32x4& kr1, u32x4& vr0, u32x4& vr1) {
    constexpr int CPR = DK / 8;
    { const int c = tid, key = c / CPR, dc = c % CPR;
      const bf16_t* src = (DK == 64 || dc < 8) ? K1 + (size_t)(64 * j + key) * ldk1 + kchunk_off<DK>(dc) : K2 + (size_t)(64 * j + key) * ldk2 + (dc - 8) * 8;
      kr0 = *(const u32x4*)src; }
    if (DK == 96) { if (tid < 256) { const int c = tid + 512, key = c / CPR, dc = c % CPR;
      const bf16_t* src = (dc < 8) ? K1 + (size_t)(64 * j + key) * ldk1 + kchunk_off<DK>(dc) : K2 + (size_t)(64 * j + key) * ldk2 + (dc - 8) * 8;
      kr1 = *(const u32x4*)src; } }
    { const int c = tid, d = c >> 3, kc = c & 7; vr0 = *(const u32x4*)(Vt + (size_t)d * MT + 64 * j + kc * 8); }
    if (DV == 128) { const int c = tid + 512, d = c >> 3, kc = c & 7; vr1 = *(const u32x4*)(Vt + (size_t)d * MT + 64 * j + kc * 8); }
}
template <int DK, int DV>
__device__ __forceinline__ void stage_store(int tid, LAS unsigned char* Kb, LAS unsigned char* Vb, const u32x4& kr0, const u32x4& kr1, const u32x4& vr0, const u32x4& vr1) {
    typedef AttnGeo<DK, DV> G; constexpr int CPR = DK / 8;
    { const int c = tid, key = c / CPR, dc = c % CPR; *(LAS u32x4*)(Kb + key * G::KS + dc * 16) = kr0; }
    if (DK == 96) { if (tid < 256) { const int c = tid + 512, key = c / CPR, dc = c % CPR; *(LAS u32x4*)(Kb + key * G::KS + dc * 16) = kr1; } }
    { const int c = tid, d = c >> 3, kc = c & 7; LAS u32x2* p = (LAS u32x2*)(Vb + d * G::VS + kc * 16); p[0] = (u32x2){vr0.x, vr0.y}; p[1] = (u32x2){vr0.z, vr0.w}; }
    if (DV == 128) { const int c = tid + 512, d = c >> 3, kc = c & 7; LAS u32x2* p = (LAS u32x2*)(Vb + d * G::VS + kc * 16); p[0] = (u32x2){vr1.x, vr1.y}; p[1] = (u32x2){vr1.z, vr1.w}; }
}
template <int DK>
__device__ __forceinline__ void qk_tile(const LAS unsigned char* Kb, int KS, const bf16x8 (&Qf)[DK / 16], int r32, int hi, f32x16& S0, f32x16& S1, float init = 0.f) {
#pragma unroll
    for (int i = 0; i < 16; ++i) { S0[i] = init; S1[i] = init; }
#pragma unroll
    for (int kk = 0; kk < DK / 16; ++kk) {
        const bf16x8 a0 = *(const LAS bf16x8*)(Kb + r32 * KS + kk * 32 + hi * 16);
        const bf16x8 a1 = *(const LAS bf16x8*)(Kb + (32 + r32) * KS + kk * 32 + hi * 16);
        S0 = __builtin_amdgcn_mfma_f32_32x32x16_bf16(a0, Qf[kk], S0, 0, 0, 0);
        S1 = __builtin_amdgcn_mfma_f32_32x32x16_bf16(a1, Qf[kk], S1, 0, 0, 0);
    }
}
template <int DV>
__device__ __forceinline__ void pv_tile(const LAS unsigned char* Vb, const f32x16& P0, const f32x16& P1, int r32, int hi, f32x16 (&O)[DV / 32]) {
#pragma unroll
    for (int T = 0; T < 2; ++T)
#pragma unroll
        for (int jj = 0; jj < 2; ++jj) {
            const f32x16& Pt = T ? P1 : P0;
            u32x4 pw; pw.x = pk2(Pt[8 * jj + 0], Pt[8 * jj + 1]); pw.y = pk2(Pt[8 * jj + 2], Pt[8 * jj + 3]); pw.z = pk2(Pt[8 * jj + 4], Pt[8 * jj + 5]); pw.w = pk2(Pt[8 * jj + 6], Pt[8 * jj + 7]);
            const bf16x8 pb = __builtin_bit_cast(bf16x8, pw);
#pragma unroll
            for (int dd = 0; dd < DV / 32; ++dd) {
                const LAS unsigned char* vp = Vb + (32 * dd + r32) * 136 + (32 * T + 16 * jj + 4 * hi) * 2;
                const u32x2 lo = *(const LAS u32x2*)vp, h2 = *(const LAS u32x2*)(vp + 16);
                const u32x4 vw = {lo.x, lo.y, h2.x, h2.y};
                O[dd] = __builtin_amdgcn_mfma_f32_32x32x16_bf16(__builtin_bit_cast(bf16x8, vw), pb, O[dd], 0, 0, 0);
            }
        }
}

template <int DK, int DV, bool FIXED>
__device__ __forceinline__ void attn_sm_pass(LAS unsigned char* lds, int tid, int wave, int lane, const bf16_t* Qp, int ldq, const bf16_t* K1, int ldk1, const bf16_t* K2, int ldk2,
                                             const bf16_t* Vt, int u, float shift, int qrope_off, f32x16 (&O)[DV / 32], float& lsum) {
    typedef AttnGeo<DK, DV> G;
    const int r32 = lane & 31, hi = lane >> 5;
    bf16x8 Qf[DK / 16];
    { const bf16_t* qp = Qp + (size_t)(256 * u + 32 * wave + r32) * ldq + 8 * hi;
#pragma unroll
      for (int kk = 0; kk < DK / 16; ++kk) { const int off = 16 * kk; Qf[kk] = *(const bf16x8*)(qp + off); } }
#pragma unroll
    for (int dd = 0; dd < DV / 32; ++dd)
#pragma unroll
        for (int i = 0; i < 16; ++i) O[dd][i] = 0.f;
    float mrun = -INFINITY, l = 0.f;
    const int ntiles = 4 * u + 4, jw = 4 * u + (wave >> 1);
    u32x4 kr0, kr1, vr0, vr1;
    stage_load<DK, DV>(tid, 0, K1, ldk1, K2, ldk2, Vt, kr0, kr1, vr0, vr1);
    stage_store<DK, DV>(tid, lds + G::KOFF, lds + G::VOFF, kr0, kr1, vr0, vr1);
    __syncthreads();
    for (int j = 0; j < ntiles; ++j) {
        const int cb = j & 1;
        if (j + 1 < ntiles) stage_load<DK, DV>(tid, j + 1, K1, ldk1, K2, ldk2, Vt, kr0, kr1, vr0, vr1);
        if (j <= jw) {
            const LAS unsigned char* Kb = lds + G::KOFF + cb * G::KBYTES; const LAS unsigned char* Vb = lds + G::VOFF + cb * G::VBYTES;
            f32x16 S0, S1;
            if (FIXED) {
                qk_tile<DK>(Kb, G::KS, Qf, r32, hi, S0, S1, -shift);
                float ps = 0.f;
#pragma unroll
                for (int i = 0; i < 16; ++i) { S0[i] = ex2(S0[i]); S1[i] = ex2(S1[i]); ps += S0[i] + S1[i]; }
                l += ps;
            } else {
                qk_tile<DK>(Kb, G::KS, Qf, r32, hi, S0, S1);
                float mx = fmaxf(S0[0], S1[0]);
#pragma unroll
                for (int i = 1; i < 16; ++i) mx = fmaxf(mx, fmaxf(S0[i], S1[i]));
                mx = x32_max(mx);
                const float mnew = fmaxf(mrun, mx), alpha = ex2(mrun - mnew); mrun = mnew;
                float ps = 0.f;
#pragma unroll
                for (int i = 0; i < 16; ++i) { S0[i] = ex2(S0[i] - mnew); S1[i] = ex2(S1[i] - mnew); ps += S0[i] + S1[i]; }
                l = l * alpha + ps;
#pragma unroll
                for (int dd = 0; dd < DV / 32; ++dd) O[dd] = O[dd] * alpha;
            }
            pv_tile<DV>(Vb, S0, S1, r32, hi, O);
        }
        if (j + 1 < ntiles) stage_store<DK, DV>(tid, lds + G::KOFF + (cb ^ 1) * G::KBYTES, lds + G::VOFF + (cb ^ 1) * G::VBYTES, kr0, kr1, vr0, vr1);
        __syncthreads();
    }
    lsum = x32_sum(l);
}

__device__ __forceinline__ float wave_max(float v) {
    v = fmaxf(v, SWZ_XOR(v, 1)); v = fmaxf(v, SWZ_XOR(v, 2)); v = fmaxf(v, SWZ_XOR(v, 4)); v = fmaxf(v, SWZ_XOR(v, 8)); v = fmaxf(v, SWZ_XOR(v, 16));
    return x32_max(v);
}
__device__ __forceinline__ void store_o32(bf16_t* rowp  , const f32x16& v, int hi) {
#pragma unroll
    for (int gp = 0; gp < 2; ++gp) { const int g = 2 * gp;
        unsigned ax = pk2(v[4 * g], v[4 * g + 1]), ay = pk2(v[4 * g + 2], v[4 * g + 3]), bx = pk2(v[4 * g + 4], v[4 * g + 5]), by = pk2(v[4 * g + 6], v[4 * g + 7]);
        { auto r = __builtin_amdgcn_permlane32_swap(ax, bx, false, false); ax = r[0]; bx = r[1]; }
        { auto r = __builtin_amdgcn_permlane32_swap(ay, by, false, false); ay = r[0]; by = r[1]; }
        *(u32x4*)(rowp + 16 * gp + (hi ? 8 : 0)) = (u32x4){ax, ay, bx, by}; }
}
__device__ __forceinline__ void attn_a_unit(KA a, LAS unsigned char* lds, int i, int l, int b, int h, int u, int wv_s) {
    const int tid = launder_tid(), lane = tid & 63, wave = __builtin_amdgcn_readfirstlane(tid >> 6);
    const float bound = uni(8.f * LOG2E * 1.01f * wave_max(fabsf(a->in[4][i * 64 + lane])) * wave_max(fabsf(a->in[5][i * 64 + lane])));
    const bf16_t* P = (const bf16_t*)(a->ws + WS_P); const bf16_t* VtA = (const bf16_t*)(a->ws + WS_VTA); bf16_t* MIX = (bf16_t*)(a->ws + WS_MIX);
    const bf16_t* Pb = P + (size_t)b * SEQ * 1536; const bf16_t* Vt = VtA + (size_t)(h * 128) * MT + (size_t)b * SEQ;
    const float lam0 = 0.8f - 0.6f * expf(-0.3f * (float)l);
    f32x16 O[4], O1[4];
#pragma nounroll
    for (int half = 0; half < 2; ++half) {
        float ls;
        if (bound < 40.f) attn_sm_pass<64, 128, true>(lds, tid, wave, lane, Pb + h * 128 + half * 64, 1536, Pb + 512 + h * 128 + half * 64, 1536, nullptr, 0, Vt, u, bound, 0, O, ls);
        else attn_sm_pass<64, 128, false>(lds, tid, wave, lane, Pb + h * 128 + half * 64, 1536, Pb + 512 + h * 128 + half * 64, 1536, nullptr, 0, Vt, u, 0.f, 0, O, ls);
        if (half == 0) { const float r = 1.f / ls;
#pragma unroll
            for (int dd = 0; dd < 4; ++dd) O1[dd] = O[dd] * r; }
        else { const float* lf = a->in[6] + i * 256; const int ln = launder_tid() & 63;
            const float s1 = wave_sum(lf[ln] * lf[64 + ln]), s2 = wave_sum(lf[128 + ln] * lf[192 + ln]);
            const float lam = uni(expf(s1) - expf(s2) + lam0);
            const float r2 = lam / ls;
#pragma unroll
            for (int dd = 0; dd < 4; ++dd) O1[dd] = O1[dd] - O[dd] * r2; }
    }
    float ss = 0.f;
#pragma unroll
    for (int dd = 0; dd < 4; ++dd)
#pragma unroll
        for (int e = 0; e < 16; ++e) ss += O1[dd][e] * O1[dd][e];
    ss = x32_sum(ss);
    const float rstd = rsqrtf(ss * (1.f / 128.f) + EPS) * (1.f - lam0);
    const float* gout = a->in[7] + i * 128;
    const int lane2 = launder_tid() & 63, r32 = lane2 & 31, hi = lane2 >> 5;
    bf16_t* orow = MIX + (size_t)(b * SEQ + 256 * u + 32 * wave + r32) * 1024 + h * 128;
#pragma unroll
    for (int dd = 0; dd < 4; ++dd) {
#pragma unroll
        for (int g = 0; g < 4; ++g) { const f32x4 gv = *(const f32x4*)(gout + 32 * dd + 8 * g + 4 * hi);
            O1[dd][4 * g] *= rstd * gv.x; O1[dd][4 * g + 1] *= rstd * gv.y; O1[dd][4 * g + 2] *= rstd * gv.z; O1[dd][4 * g + 3] *= rstd * gv.w; }
        store_o32(orow + 32 * dd, O1[dd], hi); }
}
__device__ __forceinline__ void attn_b_unit(KA a, LAS unsigned char* lds, int i, int b, int h, int u, int wv_s) {
    const int tid = launder_tid(), lane = tid & 63, wave = __builtin_amdgcn_readfirstlane(tid >> 6);
    const float mqn = wave_max(fabsf(a->in[12][i * 64 + lane])), mkn = wave_max(fabsf(a->in[14][i * 64 + lane]));
    const float mqr = wave_max(fabsf(a->in[13][i * 32 + (lane & 31)])), mkr = wave_max(fabsf(a->in[15][i * 32 + (lane & 31)]));
    const float bound = (64.f * mqn * mkn + 32.f * mqr * mkr) * 0.10206207261596575f * LOG2E * 1.01f;
    const bf16_t* P = (const bf16_t*)(a->ws + WS_P); const bf16_t* QB = (const bf16_t*)(a->ws + WS_QB); const bf16_t* KN = QB + 768;
    const bf16_t* VtB = (const bf16_t*)(a->ws + WS_VTB); bf16_t* MIX = (bf16_t*)(a->ws + WS_MIX);
    f32x16 O[2]; float l;
    const int qrope_off = 0;
    if (bound < 40.f) attn_sm_pass<96, 64, true>(lds, tid, wave, lane, QB + (size_t)b * SEQ * 1280 + h * 96, 1280, KN + (size_t)b * SEQ * 1280 + h * 64, 1280, P + (size_t)b * SEQ * 1536 + 1408, 1536,
                         VtB + (size_t)(h * 64) * MT + (size_t)b * SEQ, u, bound, qrope_off, O, l);
    else attn_sm_pass<96, 64, false>(lds, tid, wave, lane, QB + (size_t)b * SEQ * 1280 + h * 96, 1280, KN + (size_t)b * SEQ * 1280 + h * 64, 1280, P + (size_t)b * SEQ * 1536 + 1408, 1536,
                         VtB + (size_t)(h * 64) * MT + (size_t)b * SEQ, u, 0.f, qrope_off, O, l);
    const float r = 1.f / l; const int r32 = lane & 31, hi = lane >> 5;
    bf16_t* orow = MIX + (size_t)(b * SEQ + 256 * u + 32 * wave + r32) * 1024 + 512 + h * 64;
#pragma unroll
    for (int dd = 0; dd < 2; ++dd) { O[dd] = O[dd] * r; store_o32(orow + 32 * dd, O[dd], hi); }
}
__device__ __forceinline__ void attn_c_unit(KA a, LAS unsigned char* lds, int b, int h, int u, int wv_s) {
    const int tid = launder_tid(), lane = tid & 63, wave = __builtin_amdgcn_readfirstlane(tid >> 6);
    typedef AttnGeo<64, 64> G;
    const bf16_t* QK = (const bf16_t*)(a->ws + WS_QK) + (size_t)b * SEQ * 2048; const bf16_t* K1 = QK + 1024 + h * 64;
    const bf16_t* Vt = (const bf16_t*)(a->ws + WS_VTC) + (size_t)(h * 64) * MT + (size_t)b * SEQ; bf16_t* MIX = (bf16_t*)(a->ws + WS_MIX);
    const int r32 = lane & 31, hi = lane >> 5;
    const int qpos = 256 * u + 32 * wave + r32;
    bf16x8 Qf[4];
    { const bf16_t* qp = QK + (size_t)qpos * 2048 + h * 64 + 8 * hi;
#pragma unroll
      for (int kk = 0; kk < 4; ++kk) Qf[kk] = *(const bf16x8*)(qp + 16 * kk); }
    f32x16 O[2];
#pragma unroll
    for (int dd = 0; dd < 2; ++dd)
#pragma unroll
        for (int e = 0; e < 16; ++e) O[dd][e] = 0.f;
    float trun = 1.f;
    const float STICK_TINY = 1e-37f;
    bool wdone = false;
    const int ntiles = 4 * u + 4, jw = 4 * u + (wave >> 1);
    u32x4 kr0, kr1, vr0, vr1;
    stage_load<64, 64>(tid, ntiles - 1, K1, 2048, nullptr, 0, Vt, kr0, kr1, vr0, vr1);
    stage_store<64, 64>(tid, lds + G::KOFF, lds + G::VOFF, kr0, kr1, vr0, vr1);
    __syncthreads();
    for (int idx = 0; idx < ntiles; ++idx) {
        const int j = ntiles - 1 - idx, cb = idx & 1;
        if (j > 0) stage_load<64, 64>(tid, j - 1, K1, 2048, nullptr, 0, Vt, kr0, kr1, vr0, vr1);
        if (j <= jw && !wdone) {
            const LAS unsigned char* Kb = lds + G::KOFF + cb * G::KBYTES; const LAS unsigned char* Vb = lds + G::VOFF + cb * G::VBYTES;
            f32x16 Z0, Z1;
            qk_tile<64>(Kb, G::KS, Qf, r32, hi, Z0, Z1);
            const bool diag = (j == jw); const int kbase = 64 * j + 4 * hi;
#pragma unroll
            for (int e = 0; e < 16; ++e) {
                const int key = kbase + 8 * (e >> 2) + (e & 3);
                float a0 = __builtin_amdgcn_rcpf(1.f + ex2(Z0[e])), a1 = __builtin_amdgcn_rcpf(1.f + ex2(Z1[e]));
                if (diag) { if (key >= qpos) a0 = 1.f; if (key + 32 >= qpos) a1 = 1.f; }
                Z0[e] = a0; Z1[e] = a1;
            }
            float seg[8], slo[8], sup[8];
#pragma unroll
            for (int g = 0; g < 4; ++g) { seg[g] = (Z0[4 * g] * Z0[4 * g + 1]) * (Z0[4 * g + 2] * Z0[4 * g + 3]); seg[4 + g] = (Z1[4 * g] * Z1[4 * g + 1]) * (Z1[4 * g + 2] * Z1[4 * g + 3]); }
#pragma unroll
            for (int s = 0; s < 8; ++s) { auto r = __builtin_amdgcn_permlane32_swap(__float_as_uint(seg[s]), __float_as_uint(seg[s]), false, false); slo[s] = __uint_as_float(r[0]); sup[s] = __uint_as_float(r[1]); }
            float run = trun;
#pragma unroll
            for (int s = 7; s >= 0; --s) {
                float f = (hi == 0) ? run * sup[s] : run;
                run *= slo[s] * sup[s];
                f32x16& Z = (s >= 4) ? Z1 : Z0; const int g = s & 3;
#pragma unroll
                for (int r = 3; r >= 0; --r) { const float fn = f * Z[4 * g + r]; Z[4 * g + r] = f - fn; f = fn; }
            }
            trun = run;
            pv_tile<64>(Vb, Z0, Z1, r32, hi, O);
            wdone = (__ballot(trun >= STICK_TINY) == 0ull);
        }
        if (j > 0) stage_store<64, 64>(tid, lds + G::KOFF + (cb ^ 1) * G::KBYTES, lds + G::VOFF + (cb ^ 1) * G::VBYTES, kr0, kr1, vr0, vr1);
        {
            volatile LAS unsigned* fl = (volatile LAS unsigned*)(lds + 131072 + 32 + (idx & 1) * 32);
            if (lane == 0) fl[wave] = wdone ? 1u : 0u;
            __syncthreads();
            const unsigned all = fl[0] & fl[1] & fl[2] & fl[3] & fl[4] & fl[5] & fl[6] & fl[7];
            if (all) break;
        }
    }
    bf16_t* orow = MIX + (size_t)(b * SEQ + qpos) * 1024 + h * 64;
#pragma unroll
    for (int dd = 0; dd < 2; ++dd) store_o32(orow + 32 * dd, O[dd], hi);
}


#define XB_TMO      128
#define XB_XCNT(j)  (256  + 64 * (j))
#define XB_XSUB(j)  (1280 + 64 * (j))
#define XB_XGEN(j)  (2304 + 64 * (j))
#define XB_TOP      3328
#define XB_TOPGEN   3392
#define XCD_BAR_WORDS 3456
#define XB_SPIN_CAP (1u << 18)
__device__ __forceinline__ unsigned xb_ld(unsigned* p)              { return __hip_atomic_load(p, __ATOMIC_RELAXED, __HIP_MEMORY_SCOPE_AGENT); }
__device__ __forceinline__ unsigned xb_add(unsigned* p, unsigned v) { return __hip_atomic_fetch_add(p, v, __ATOMIC_RELAXED, __HIP_MEMORY_SCOPE_AGENT); }
__device__ __forceinline__ unsigned xb_xcc_id() { return (unsigned)__builtin_amdgcn_s_getreg((3 << 11) | 20) & 0xFu; }
#define XB_SPIN(cond, bar) do { unsigned _sp = 0; while (cond) { __builtin_amdgcn_s_sleep(1); \
    if ((++_sp & 255u) == 0u) { if (xb_ld(&(bar)[XB_TMO])) break; if (_sp > XB_SPIN_CAP) { atomicAdd(&(bar)[XB_TMO], 1u); break; } } } } while (0)
struct XcdBarrier { unsigned* bar; unsigned x; volatile LAS unsigned* st; };
__device__ __forceinline__ XcdBarrier xcd_barrier_post(unsigned* bar, volatile LAS unsigned* st) {
    XcdBarrier b; b.bar = bar; b.x = xb_xcc_id(); b.st = st;
    if (threadIdx.x == 0) (void)xb_add(&bar[XB_XCNT(b.x)], 1u);
    return b;
}
__device__ __forceinline__ void xcd_barrier_complete(unsigned* bar, unsigned x, unsigned& nloc, unsigned& nx) {
    const unsigned G = gridDim.x * gridDim.y * gridDim.z;
    unsigned sum, cnt, mine, sp = 0u;
    for (;;) {
        sum = 0u; cnt = 0u; mine = 0u;
#pragma unroll
        for (unsigned j = 0; j < 16; ++j) { const unsigned c = xb_ld(&bar[XB_XCNT(j)]); sum += c; cnt += (c > 0u) ? 1u : 0u; mine = (j == x) ? c : mine; }
        if (sum == G) break;
        __builtin_amdgcn_s_sleep(1);
        if ((++sp & 255u) == 0u) { if (xb_ld(&bar[XB_TMO])) break; if (sp > XB_SPIN_CAP) { atomicAdd(&bar[XB_TMO], 1u); break; } }
    }
    nloc = mine > 0u ? mine : 1u; nx = cnt > 0u ? cnt : 1u;
}
__device__ __forceinline__ void xcd_barrier(const XcdBarrier& b, int tid) {
    asm volatile("s_waitcnt vmcnt(0)" ::: "memory");
    __syncthreads();
    if (tid == 0) {
        unsigned* bar = b.bar;
        __builtin_amdgcn_s_waitcnt(0);
        unsigned nloc = b.st[0], nx = b.st[1];
        if (nloc == 0u) { xcd_barrier_complete(bar, b.x, nloc, nx); b.st[0] = nloc; b.st[1] = nx; }
        const unsigned old = xb_add(&bar[XB_XSUB(b.x)], 1u);
        const unsigned gen = old / nloc;
        if (old + 1u == (gen + 1u) * nloc) {
            __builtin_amdgcn_fence(__ATOMIC_RELEASE, "agent");
            asm volatile("s_waitcnt vmcnt(0)" ::: "memory");
            const unsigned og = xb_add(&bar[XB_TOP], 1u);
            const unsigned tg = og / nx;
            if (og + 1u == (tg + 1u) * nx) xb_add(&bar[XB_TOPGEN], 1u);
            else XB_SPIN(xb_ld(&bar[XB_TOPGEN]) == tg, bar);
            __builtin_amdgcn_fence(__ATOMIC_ACQUIRE, "agent");
            xb_add(&bar[XB_XGEN(b.x)], 1u);
            asm volatile("s_waitcnt vmcnt(0)" ::: "memory");
        } else {
            XB_SPIN(xb_ld(&bar[XB_XGEN(b.x)]) == gen, bar);
            __builtin_amdgcn_fence(__ATOMIC_ACQUIRE, "agent");
            asm volatile("s_waitcnt vmcnt(0)" ::: "memory");
        }
    }
    __syncthreads();
}

__global__ void __launch_bounds__(512, 2) fwd_megakernel(Args a_unused) {
    extern __shared__ __attribute__((aligned(16))) unsigned char lds_raw[];
    LAS unsigned char* lds = (LAS unsigned char*)lds_raw;
    cg::grid_group grid = cg::this_grid();
    const int G = gridDim.x, bid = blockIdx.x, NGW = G * 8;
    const int wv_s = __builtin_amdgcn_readfirstlane(threadIdx.x >> 6);
    if (threadIdx.x < 32) ((LAS unsigned*)(lds + 131072))[threadIdx.x] = 0u;
    __syncthreads();
    if (blockIdx.x == 0) { unsigned* bw = (unsigned*)(ka_get()->ws + WS_CTL); for (int q = threadIdx.x; q < XCD_BAR_WORDS; q += 512) __hip_atomic_store(bw + q, 0u, __ATOMIC_RELAXED, __HIP_MEMORY_SCOPE_AGENT); }
#define GSYNC() do { XcdBarrier xb_; xb_.bar = (unsigned*)(ka_get()->ws + WS_CTL); xb_.x = xb_xcc_id(); xb_.st = (volatile LAS unsigned*)(lds + 131072); xcd_barrier(xb_, launder_tid()); } while (0)
#define WSP (ka_get()->ws)
#define OUTP (ka_get()->out)

    prep_phase(ka_get(), lds, NGW, wv_s);
    { KA a = ka_get(); norm_phase(a->in[0], (bf16_t*)(a->ws + WS_XB), (float*)(a->ws + WS_SS), NGW, wv_s); }
    grid.sync();
    (void)xcd_barrier_post((unsigned*)(ka_get()->ws + WS_CTL), (volatile LAS unsigned*)(lds + 131072));

    for (int l = 0; l < 4; ++l) {
        const int i = l >> 1;
        {
            const bool odd = (l & 1);
            for (int jb = 0; jb < 2; ++jb) {
                unsigned char* ws = WSP; const bf16_t* XB = (const bf16_t*)(ws + WS_XB);
                unsigned char* wb = odd ? ws + WS_ODD + i * ODD_STRIDE : ws + WS_EVEN + i * EVEN_STRIDE;
                const bf16_t *A, *Bt; int Mg, Ng; pg8::EpiStore E; pg8::StaticOrder S;
                if (jb == 0) { A = XB; Bt = (const bf16_t*)wb; Mg = MT; Ng = odd ? 2048 : 1536; E = pg8::EpiStore{(bf16_t*)(ws + WS_R), Ng, odd ? 0.125f * LOG2E : 1.f, odd ? 4 : 0, (const float*)(ws + WS_SS), 1}; }
                else { A = (const bf16_t*)(wb + (odd ? 4 : 3) * MiB); Bt = XB; Mg = odd ? 1024 : 512; Ng = MT; E = pg8::EpiStore{(bf16_t*)(ws + (odd ? WS_VTC : WS_VTA)), MT, 1.f, 0, (const float*)(ws + WS_SS), 2}; }
                S.init(Mg, Ng, G, bid);
                pg8::gemm_phase<pg8::EpiStore, 1024, 1024, 1024>(lds, A, Bt, S, E, wv_s);
            }
        }
        GSYNC();
        if ((l & 1) == 0) {
            post_e2(ka_get(), i, NGW, wv_s);
            GSYNC();
            {
                { unsigned char* ws = WSP; unsigned char* wb = ws + WS_EVEN + i * EVEN_STRIDE; const bf16_t* P = (const bf16_t*)(ws + WS_P);
                  KA a = ka_get();
                  pg8::EpiLatent E{(bf16_t*)(ws + WS_QB), a->in[12] + i * 64, a->in[13] + i * 32, a->in[14] + i * 64, (const float2*)(ws + WS_ROPE + 512 * 1024), 0.10206207261596575f * LOG2E, 0}; pg8::StaticOrder S; S.init(MT, 768, G, bid);
                  pg8::gemm_phase<pg8::EpiLatent, 256, 1536, 384>(lds, P + 1024, (const bf16_t*)(wb + 6 * MiB), S, E, wv_s); }
                { unsigned char* ws = WSP; unsigned char* wb = ws + WS_EVEN + i * EVEN_STRIDE; const bf16_t* P = (const bf16_t*)(ws + WS_P);
                  KA a = ka_get();
                  pg8::EpiLatent E{(bf16_t*)(ws + WS_QB), a->in[12] + i * 64, a->in[13] + i * 32, a->in[14] + i * 64, (const float2*)(ws + WS_ROPE + 512 * 1024), 0.10206207261596575f * LOG2E, 3}; pg8::StaticOrder S; S.init(MT, 512, G, bid);
                  pg8::gemm_phase<pg8::EpiLatent, 128, 1536, 384>(lds, P + 1280, (const bf16_t*)(wb + 6 * MiB) + 768 * 384 + 256, S, E, wv_s); }
                { unsigned char* ws = WSP; unsigned char* wb = ws + WS_EVEN + i * EVEN_STRIDE; const bf16_t* P = (const bf16_t*)(ws + WS_P);
                  pg8::EpiStore E{(bf16_t*)(ws + WS_VTB), MT, 1.f, 0, nullptr, 0}; pg8::StaticOrder S; S.init(512, MT, G, bid);
                  pg8::gemm_phase<pg8::EpiStore, 128, 384, 1536>(lds, (const bf16_t*)(wb + 6 * MiB + 960 * 1024) + 256, P + 1280, S, E, wv_s); }
            }
            GSYNC();
            {
                const int vb = (G % 8 == 0) ? (bid & 7) * (G >> 3) + (bid >> 3) : bid;
                for (int rep = 0; rep < ATT_REP; ++rep)
                for (int it = vb; it < 768; it += G) {
                    if (it < 256) { const int b = it >> 4, h = (it >> 2) & 3, up = it & 3;
                        for (int k = 0; k < 2; ++k) attn_a_unit(ka_get(), lds, i, l, b, h, k ? up : 7 - up, wv_s); }
                    else { const int p = it - 256, b = p >> 5, h = (p >> 2) & 7, up = p & 3;
                        for (int k = 0; k < 2; ++k) attn_b_unit(ka_get(), lds, i, b, h, k ? up : 7 - up, wv_s); }
                }
            }
        } else {
            const int vb = (G % 8 == 0) ? (bid & 7) * (G >> 3) + (bid >> 3) : bid;
            for (int rep = 0; rep < ATT_REP_O; ++rep)
            for (int it = vb; it < 1024; it += G) { const int b = it >> 6, h = (it >> 2) & 15, up = it & 3;
                for (int k = 0; k < 2; ++k) attn_c_unit(ka_get(), lds, b, h, k ? up : 7 - up, wv_s); }
        }
        GSYNC();
        {
            unsigned char* ws = WSP;
            const bf16_t* Wo = (l & 1) ? (const bf16_t*)(ws + WS_ODD + i * ODD_STRIDE + 6 * MiB) : (const bf16_t*)(ws + WS_EVEN + i * EVEN_STRIDE + 4 * MiB);
            pg8::EpiResid E{nullptr, 1024, (bf16_t*)(ws + WS_XB), (float*)(ws + WS_SS)}; pg8::StaticOrder S; S.init(MT, 1024, G, bid);
            pg8::gemm_phase<pg8::EpiResid, 1024, 1024, 1024>(lds, (const bf16_t*)(ws + WS_MIX), Wo, S, E, wv_s);
        }
        GSYNC();
        for (int rep = 0; rep < GU_REP; ++rep)
        { unsigned char* ws = WSP; unsigned char* wf = ws + WS_FFN + l * FFN_STRIDE;
          pg8::EpiSwiglu E{(bf16_t*)(ws + WS_ACT), DFF, (const float*)(ws + WS_SS)}; pg8::StaticOrder S; S.init(MT, 2 * DFF, G, bid);
          pg8::gemm_phase<pg8::EpiSwiglu, 1024, 1024, 1024>(lds, (const bf16_t*)(ws + WS_XB), (const bf16_t*)wf, S, E, wv_s); }
        GSYNC();
        { KA a = ka_get(); unsigned char* ws = a->ws; float* out = a->out; unsigned char* wf = ws + WS_FFN + l * FFN_STRIDE;
          pg8::EpiResid E{(l == 3) ? out : nullptr, 1024, (bf16_t*)(ws + WS_XB), (float*)(ws + WS_SS)}; pg8::StaticOrder S; S.init(MT, 1024, G, bid);
          pg8::gemm_phase<pg8::EpiResid, DFF, DFF, DFF>(lds, (const bf16_t*)(ws + WS_ACT), (const bf16_t*)(wf + 11 * MiB), S, E, wv_s); }
        GSYNC();
    }
}

extern "C" void kernel_launch(void* const* d_in, const int* in_sizes, int n_in, void* d_out, int out_size, void* d_ws, size_t ws_size, hipStream_t stream) {
    static int grid = 0;
    if (grid == 0) {
        if (n_in != 22 || ws_size < WS_END) { fprintf(stderr, "kernel_launch: unexpected n_in %d or ws_size %zu\n", n_in, ws_size); grid = -1; return; }
        int dev = 0, cus = 0, per_cu = 0;
        hipGetDevice(&dev);
        hipDeviceGetAttribute(&cus, hipDeviceAttributeMultiprocessorCount, dev);
        if (hipFuncSetAttribute((const void*)fwd_megakernel, hipFuncAttributeMaxDynamicSharedMemorySize, LDS_BYTES) != hipSuccess) { fprintf(stderr, "kernel_launch: hipFuncSetAttribute failed\n"); grid = -1; return; }
        hipOccupancyMaxActiveBlocksPerMultiprocessor(&per_cu, (const void*)fwd_megakernel, 512, LDS_BYTES);
        if (per_cu < 1) per_cu = 1;
        (void)hipGetLastError();
        grid = cus * per_cu;
    }
    if (grid < 0) return;
    Args a{};
    for (int i = 0; i < 22; ++i) a.in[i] = (const float*)d_in[i];
    a.out = (float*)d_out; a.ws = (unsigned char*)d_ws;
    void* args[] = {&a};
    hipError_t e = hipLaunchCooperativeKernel((const void*)fwd_megakernel, dim3(grid), dim3(512), args, LDS_BYTES, stream);
    if (e != hipSuccess) fprintf(stderr, "cooperative launch failed: %s (grid %d)\n", hipGetErrorString(e), grid);
}
```

```cpp
#include <hip/hip_runtime.h>
#include <hip/hip_cooperative_groups.h>
#include <cstdio>
#include <cstdint>
namespace cg = cooperative_groups;

#define LAS __attribute__((address_space(3)))
typedef unsigned short bf16_t;
typedef short bf16x8 __attribute__((ext_vector_type(8)));
typedef short s16x4 __attribute__((ext_vector_type(4)));
typedef float f32x4 __attribute__((ext_vector_type(4)));
typedef float f32x16 __attribute__((ext_vector_type(16)));
typedef unsigned u32x4 __attribute__((ext_vector_type(4)));
typedef unsigned u32x2 __attribute__((ext_vector_type(2)));
typedef float f32x2_t __attribute__((ext_vector_type(2)));
typedef __bf16 bf16x2_t __attribute__((ext_vector_type(2)));

__device__ __forceinline__ unsigned pk2(float lo, float hi) { f32x2_t v = {lo, hi}; bf16x2_t b = __builtin_convertvector(v, bf16x2_t); return __builtin_bit_cast(unsigned, b); }
__device__ __forceinline__ float bflo(unsigned w) { return __uint_as_float(w << 16); }
__device__ __forceinline__ float bfhi(unsigned w) { return __uint_as_float(w & 0xffff0000u); }
__device__ __forceinline__ int launder_tid_(int wv_s) { int ln; asm volatile("v_mbcnt_lo_u32_b32 %0, -1, 0\n\tv_mbcnt_hi_u32_b32 %0, -1, %0" : "=v"(ln)); return wv_s * 64 + ln; }
#define launder_tid() launder_tid_(wv_s)

#define SWZ_XOR(v, m) __int_as_float(__builtin_amdgcn_ds_swizzle(__float_as_int(v), (((m) << 10) | 0x1f)))
__device__ __forceinline__ float x32_sum(float v) { auto r = __builtin_amdgcn_permlane32_swap(__float_as_uint(v), __float_as_uint(v), false, false); return __uint_as_float(r[0]) + __uint_as_float(r[1]); }
__device__ __forceinline__ float x32_max(float v) { auto r = __builtin_amdgcn_permlane32_swap(__float_as_uint(v), __float_as_uint(v), false, false); return fmaxf(__uint_as_float(r[0]), __uint_as_float(r[1])); }
__device__ __forceinline__ float uni(float v) { return __uint_as_float(__builtin_amdgcn_readfirstlane(__float_as_uint(v))); }
__device__ __forceinline__ float ex2(float x) { return __builtin_amdgcn_exp2f(x); }
__device__ __forceinline__ float lg2(float x) { return __builtin_amdgcn_logf(x); }

namespace pg8 {
constexpr int BM = 256, BK = 64, HALF = 128, HTB = HALF * BK * 2, STAGE_BYTES = 8 * HTB, NXCD = 8, WGM = 4;
__host__ __device__ __forceinline__ int lds_byte(int r, int c) { const int st = (r >> 4) * 2 + (c >> 5), rr = r & 15, cc = c & 31, ob = rr * 64 + cc * 2; return st * 1024 + (ob ^ (((ob >> 9) & 1) << 5)); }
__host__ __device__ __forceinline__ void stage_rc(int b, int& R, int& C) { const int st = b / 1024, sb = b % 1024, swz = sb ^ (((sb >> 9) & 1) << 5); R = (st >> 1) * 16 + swz / 64; C = (st & 1) * 32 + (swz % 64) / 2; }
__host__ __device__ __forceinline__ int perm32(int rho) { const int n = rho >> 4, i = rho & 15; return 8 * (i >> 2) + 4 * n + (i & 3); }

struct Unit { int pm, pn; };

struct StaticOrder {
    int nM, nN, nwg, G, c;
    __device__ void init(int M, int N, int G_, int c_) { nM = M / BM; nN = N / BM; nwg = nM * nN; G = G_; c = c_; }
    __device__ bool next(int i, Unit& u) const {
        const long L = (long)i * G + c; if (L >= nwg) return false;
        int wgid = (int)L; { const int q = nwg / NXCD, r = nwg % NXCD, xcd = wgid % NXCD, off = wgid / NXCD; wgid = (xcd < r ? xcd * (q + 1) : r * (q + 1) + (xcd - r) * q) + off; }
        const int nig = WGM * nN, gid = wgid / nig, fm = gid * WGM, gsz = (nM - fm) < WGM ? (nM - fm) : WGM;
        u.pm = fm + ((wgid % nig) % gsz); u.pn = (wgid % nig) / gsz; return true;
    }
};

__device__ __forceinline__ float rstd_row4(const float* ss, int row, int fq) {
    const f32x4 a = *(const f32x4*)(ss + (size_t)row * 16 + fq * 4);
    float t = (a.x + a.y) + (a.z + a.w);
    t += SWZ_XOR(t, 16); t = x32_sum(t);
    return rsqrtf(t * (1.f / 1024.f) + 1e-6f);
}
__device__ __forceinline__ float rstd_row16(const float* ss, int row) {
    const f32x4* p = (const f32x4*)(ss + (size_t)row * 16); const f32x4 a = p[0], b = p[1], c = p[2], d = p[3];
    const float t = (((a.x + a.y) + (a.z + a.w)) + ((b.x + b.y) + (b.z + b.w))) + (((c.x + c.y) + (c.z + c.w)) + ((d.x + d.y) + (d.z + d.w)));
    return rsqrtf(t * (1.f / 1024.f) + 1e-6f);
}
struct EpiStore {
    static constexpr bool PERM = true;
    bf16_t* O; int ldc; float scale; int nsc; const float* ss; int mode;
    __device__ __forceinline__ void operator()(const f32x4 (&acc)[2][2][4][2], const Unit& u, int wr, int wc, int fr, int fq) const {
        const int row0 = u.pm * BM + wr * 64 + fr, col0 = u.pn * BM + wc * 32 + 8 * fq;
        const float sc = (u.pn < nsc) ? scale : 1.f;
        if (mode == 2) {
            const float mine = rstd_row16(ss, col0 + (fr >> 3) * HALF + (fr & 7)) * sc;
            float cs[2][8];
#pragma unroll
            for (int bj = 0; bj < 2; ++bj)
#pragma unroll
                for (int e = 0; e < 8; ++e) cs[bj][e] = __int_as_float(__builtin_amdgcn_ds_bpermute((fq * 16 + bj * 8 + e) << 2, __float_as_int(mine)));
#pragma unroll
            for (int ai = 0; ai < 2; ++ai)
#pragma unroll
                for (int m = 0; m < 4; ++m) { bf16_t* rowp = O + (size_t)(row0 + ai * HALF + m * 16) * ldc + col0;
#pragma unroll
                    for (int bj = 0; bj < 2; ++bj) { const f32x4 v0 = acc[ai][bj][m][0], v1 = acc[ai][bj][m][1];
                        u32x4 w; w.x = pk2(v0[0] * cs[bj][0], v0[1] * cs[bj][1]); w.y = pk2(v0[2] * cs[bj][2], v0[3] * cs[bj][3]); w.z = pk2(v1[0] * cs[bj][4], v1[1] * cs[bj][5]); w.w = pk2(v1[2] * cs[bj][6], v1[3] * cs[bj][7]);
                        *(u32x4*)(rowp + bj * HALF) = w; } }
        } else {
            float rsv[2][4];
#pragma unroll
            for (int ai = 0; ai < 2; ++ai)
#pragma unroll
                for (int m = 0; m < 4; ++m) { rsv[ai][m] = sc; if (mode == 1) rsv[ai][m] *= rstd_row4(ss, row0 + ai * HALF + m * 16, fq); }
#pragma unroll
            for (int ai = 0; ai < 2; ++ai)
#pragma unroll
                for (int m = 0; m < 4; ++m) { const int row = row0 + ai * HALF + m * 16; bf16_t* rowp = O + (size_t)row * ldc + col0;
                    const float rs = rsv[ai][m];
#pragma unroll
                    for (int bj = 0; bj < 2; ++bj) { const f32x4 v0 = acc[ai][bj][m][0] * rs, v1 = acc[ai][bj][m][1] * rs;
                        u32x4 w; w.x = pk2(v0[0], v0[1]); w.y = pk2(v0[2], v0[3]); w.z = pk2(v1[0], v1[1]); w.w = pk2(v1[2], v1[3]);
                        *(u32x4*)(rowp + bj * HALF) = w; } }
        }
    }
};

struct EpiLatent {
    static constexpr bool PERM = true;
    bf16_t* O; const float* gqn; const float* gqr; const float* gkn; const float2* tab32; float qscale; int pn_off;
    __device__ __forceinline__ void operator()(const f32x4 (&acc)[2][2][4][2], const Unit& u, int wr, int wc, int fr, int fq) const {
        const int row0 = u.pm * BM + wr * 64 + fr; const int tp = u.pn + pn_off;
        if (tp != 2) {
            const float* g = (tp < 2) ? gqn : gkn; const float sc = (tp < 2) ? qscale : 1.f;
            f32x4 gv[2][2];
#pragma unroll
            for (int bj = 0; bj < 2; ++bj)
#pragma unroll
                for (int n = 0; n < 2; ++n) gv[bj][n] = *(const f32x4*)(g + 32 * bj + 8 * fq + 4 * n) * sc;
#pragma unroll
            for (int ai = 0; ai < 2; ++ai)
#pragma unroll
                for (int m = 0; m < 4; ++m) { bf16_t* rowp = O + (size_t)(row0 + ai * HALF + m * 16) * 1280 + ((tp < 2) ? 96 * (4 * tp + wc) : 768 + 64 * (4 * (tp - 3) + wc)) + 8 * fq;
                    float ss = 0.f;
#pragma unroll
                    for (int bj = 0; bj < 2; ++bj)
#pragma unroll
                        for (int n = 0; n < 2; ++n) { const f32x4 v = acc[ai][bj][m][n]; ss += (v[0] * v[0] + v[1] * v[1]) + (v[2] * v[2] + v[3] * v[3]); }
                    ss += SWZ_XOR(ss, 16); ss = x32_sum(ss);
                    const float rstd = rsqrtf(ss * (1.f / 64.f) + 1e-6f);
#pragma unroll
                    for (int bj = 0; bj < 2; ++bj) { const f32x4 v0 = acc[ai][bj][m][0] * rstd * gv[bj][0], v1 = acc[ai][bj][m][1] * rstd * gv[bj][1];
                        u32x4 w; w.x = pk2(v0[0], v0[1]); w.y = pk2(v0[2], v0[3]); w.z = pk2(v1[0], v1[1]); w.w = pk2(v1[2], v1[3]);
                        *(u32x4*)(rowp + bj * 32) = w; } }
        } else {
            const int ib = 8 * (fq & 1); const bool up = (fq >= 2);
            f32x4 gv[2];
#pragma unroll
            for (int n = 0; n < 2; ++n) gv[n] = *(const f32x4*)(gqr + 8 * fq + 4 * n);
#pragma unroll
            for (int ai = 0; ai < 2; ++ai)
#pragma unroll
                for (int m = 0; m < 4; ++m) { const int row = row0 + ai * HALF + m * 16; bf16_t* rowp = O + (size_t)row * 1280 + 96 * wc + 64 + 8 * fq;
                    const f32x4* tp = (const f32x4*)(tab32 + (size_t)(row & (2048 - 1)) * 16 + ib);
                    const f32x4 t0 = tp[0], t1 = tp[1], t2 = tp[2], t3 = tp[3];
                    const float cs[8] = {t0.x, t0.z, t1.x, t1.z, t2.x, t2.z, t3.x, t3.z}, sn[8] = {t0.y, t0.w, t1.y, t1.w, t2.y, t2.w, t3.y, t3.w};
#pragma unroll
                    for (int bj = 0; bj < 2; ++bj) {
                        const f32x4 a0 = acc[ai][bj][m][0], a1 = acc[ai][bj][m][1];
                        float ss = (a0[0] * a0[0] + a0[1] * a0[1]) + (a0[2] * a0[2] + a0[3] * a0[3]) + (a1[0] * a1[0] + a1[1] * a1[1]) + (a1[2] * a1[2] + a1[3] * a1[3]);
                        ss += SWZ_XOR(ss, 16); ss = x32_sum(ss);
                        const float rstd = rsqrtf(ss * (1.f / 32.f) + 1e-6f) * qscale;
                        float y[8], o[8];
#pragma unroll
                        for (int e = 0; e < 4; ++e) { y[e] = a0[e] * rstd * gv[0][e]; y[4 + e] = a1[e] * rstd * gv[1][e]; }
#pragma unroll
                        for (int e = 0; e < 8; ++e) { auto r = __builtin_amdgcn_permlane32_swap(__float_as_uint(y[e]), __float_as_uint(y[e]), false, false);
                            const float y1 = __uint_as_float(r[0]), y2 = __uint_as_float(r[1]);
                            o[e] = up ? (y2 * cs[e] + y1 * sn[e]) : (y1 * cs[e] - y2 * sn[e]); }
                        u32x4 w; w.x = pk2(o[0], o[1]); w.y = pk2(o[2], o[3]); w.z = pk2(o[4], o[5]); w.w = pk2(o[6], o[7]);
                        *(u32x4*)(rowp + bj * 384) = w; } }
        }
    }
};
__device__ __forceinline__ float silu_mul(float g, float u) { return g * __builtin_amdgcn_rcpf(1.f + ex2(-1.4426950408889634f * g)) * u; }
struct EpiSwiglu {
    static constexpr bool PERM = true;
    bf16_t* O; int ldc; const float* ss;
    __device__ __forceinline__ void operator()(const f32x4 (&acc)[2][2][4][2], const Unit& u, int wr, int wc, int fr, int fq) const {
        const int row0 = u.pm * BM + wr * 64 + fr, col0 = u.pn * HALF + wc * 32 + 8 * fq;
        float rsv[2][4];
#pragma unroll
        for (int ai = 0; ai < 2; ++ai)
#pragma unroll
            for (int m = 0; m < 4; ++m) rsv[ai][m] = rstd_row4(ss, row0 + ai * HALF + m * 16, fq);
#pragma unroll
        for (int ai = 0; ai < 2; ++ai)
#pragma unroll
            for (int m = 0; m < 4; ++m) { const int row = row0 + ai * HALF + m * 16; bf16_t* rowp = O + (size_t)row * ldc + col0; const float rs = rsv[ai][m];
                const f32x4 g0 = acc[ai][0][m][0] * rs, g1 = acc[ai][0][m][1] * rs, u0 = acc[ai][1][m][0] * rs, u1 = acc[ai][1][m][1] * rs;
                u32x4 w; w.x = pk2(silu_mul(g0[0], u0[0]), silu_mul(g0[1], u0[1])); w.y = pk2(silu_mul(g0[2], u0[2]), silu_mul(g0[3], u0[3]));
                w.z = pk2(silu_mul(g1[0], u1[0]), silu_mul(g1[1], u1[1])); w.w = pk2(silu_mul(g1[2], u1[2]), silu_mul(g1[3], u1[3]));
                *(u32x4*)rowp = w; }
    }
};
struct EpiResid {
    static constexpr bool PERM = false;
    float* out; int ldc; bf16_t* xb; float* ss;
    __device__ __forceinline__ void operator()(const f32x4 (&acc)[2][2][4][2], const Unit& u, int wr, int wc, int fr, int fq) const {
        const int row0 = u.pm * BM + wr * 64 + fr, col0 = u.pn * BM + wc * 32 + 4 * fq;
#pragma unroll
        for (int ai = 0; ai < 2; ++ai) {
            u32x2 bv[4][2][2];
#pragma unroll
            for (int m = 0; m < 4; ++m)
#pragma unroll
                for (int bj = 0; bj < 2; ++bj)
#pragma unroll
                    for (int n = 0; n < 2; ++n) bv[m][bj][n] = *(const u32x2*)(xb + (size_t)(row0 + ai * HALF + m * 16) * ldc + col0 + bj * HALF + n * 16);
            asm volatile("" ::: "memory");
#pragma unroll
            for (int m = 0; m < 4; ++m) { const int row = row0 + ai * HALF + m * 16; const size_t off = (size_t)row * ldc + col0; float sq = 0.f;
#pragma unroll
                for (int bj = 0; bj < 2; ++bj)
#pragma unroll
                    for (int n = 0; n < 2; ++n) { const size_t p = off + bj * HALF + n * 16; const u32x2 b = bv[m][bj][n];
                        f32x4 v = acc[ai][bj][m][n]; v[0] += bflo(b.x); v[1] += bfhi(b.x); v[2] += bflo(b.y); v[3] += bfhi(b.y);
                        if (out) { *(f32x4*)(out + p) = v; }
                        else { sq += (v[0] * v[0] + v[1] * v[1]) + (v[2] * v[2] + v[3] * v[3]);
                               u32x2 w; w.x = pk2(v[0], v[1]); w.y = pk2(v[2], v[3]); *(u32x2*)(xb + p) = w; } }
                if (!out) { sq += SWZ_XOR(sq, 16); sq = x32_sum(sq);
                            if (fq == 0) ss[(size_t)row * 16 + u.pn * 4 + wc] = sq; } }
            asm volatile("" ::: "memory");
        }
    }
};

template <class Epi, int K, int LDA, int LDB>
__device__ __forceinline__ void gemm_phase(LAS unsigned char* lds, const bf16_t* gA, const bf16_t* gBt, const StaticOrder& S, const Epi& E, int wv_s) {
    const int tid = launder_tid(), wid = __builtin_amdgcn_readfirstlane(tid >> 6), lane = tid & 63, wr = wid >> 2, wc = wid & 3, fr = lane & 15, fq = lane >> 4;
    int nt = K / BK; asm volatile("" : "+s"(nt));
    unsigned voffA[2], voffB[2];
#pragma unroll
    for (int i = 0; i < 2; ++i) { int R, C; stage_rc(tid * 16 + i * 8192, R, C); const int Rb = Epi::PERM ? ((R & ~31) + perm32(R & 31)) : R;
        voffA[i] = (unsigned)(R * LDA + C) * 2u; voffB[i] = (unsigned)(Rb * LDB + C) * 2u; }
    constexpr size_t kstep = (size_t)(BK * 2);
    constexpr size_t hsA = (size_t)HALF * LDA * 2, hsB = (size_t)HALF * LDB * 2;
    constexpr size_t tsA = 2 * hsA, tsB = 2 * hsB;
    const unsigned ldsw = (unsigned)wid * 1024u;
    const int aoff = lds_byte(wr * 64 + fr, fq * 8), boff = lds_byte(wc * 32 + fr, fq * 8);
#define PG8_SA(b, h) (((b) * 2 + (h)) * HTB)
#define PG8_SB(b, h) ((4 + (b) * 2 + (h)) * HTB)
#define PG8_STAGE(bufoff, gbase, voff) do { _Pragma("unroll") for (int _i = 0; _i < 2; ++_i) \
        __builtin_amdgcn_global_load_lds((const unsigned*)((const char*)(gbase) + (voff)[_i]), (LAS unsigned*)(lds + (bufoff) + ldsw + _i * 8192), 16, 0, 0); } while (0)
#define PG8_LDA(dst, b, h) do { _Pragma("unroll") for (int m = 0; m < 4; ++m) _Pragma("unroll") for (int k = 0; k < 2; ++k) dst[m][k] = *(const LAS bf16x8*)(lds + PG8_SA(b, h) + aoff + m * 2048 + k * 1024); } while (0)
#define PG8_LDB(dst, b, h) do { _Pragma("unroll") for (int n = 0; n < 2; ++n) _Pragma("unroll") for (int k = 0; k < 2; ++k) dst[n][k] = *(const LAS bf16x8*)(lds + PG8_SB(b, h) + boff + n * 2048 + k * 1024); } while (0)
#define PG8_MMA(ai, bj, At, Bt) do { __builtin_amdgcn_s_setprio(1); _Pragma("unroll") for (int m = 0; m < 4; ++m) _Pragma("unroll") for (int n = 0; n < 2; ++n) _Pragma("unroll") for (int k = 0; k < 2; ++k) \
        acc[ai][bj][m][n] = __builtin_amdgcn_mfma_f32_16x16x32_bf16(Bt[n][k], At[m][k], acc[ai][bj][m][n], 0, 0, 0); __builtin_amdgcn_s_setprio(0); } while (0)
#define PG8_WAIT_V(n) asm volatile("s_waitcnt vmcnt(" #n ")" ::: "memory")
#define PG8_WAIT_L(n) asm volatile("s_waitcnt lgkmcnt(" #n ")" ::: "memory")
#define PG8_BAR __builtin_amdgcn_s_barrier()
#define PG8_SCHED __builtin_amdgcn_sched_barrier(0)
    Unit cur, nxt; int ui = 0;
    if (!S.next(0, cur)) return;
    f32x4 acc[2][2][4][2];
#pragma unroll
    for (int a = 0; a < 2; ++a)
#pragma unroll
        for (int b = 0; b < 2; ++b)
#pragma unroll
            for (int m = 0; m < 4; ++m)
#pragma unroll
                for (int n = 0; n < 2; ++n) acc[a][b][m][n] = (f32x4){0.f, 0.f, 0.f, 0.f};
    bf16x8 At[4][2], B0[2][2], B1[2][2];
    const char* cA = (const char*)gA + (size_t)cur.pm * tsA; const char* cB = (const char*)gBt + (size_t)cur.pn * tsB;
    PG8_STAGE(PG8_SB(0, 0), cB, voffB); PG8_STAGE(PG8_SB(0, 1), cB + hsB, voffB); PG8_STAGE(PG8_SA(0, 0), cA, voffA); PG8_STAGE(PG8_SA(0, 1), cA + hsA, voffA);
    if (wr == 1) PG8_BAR;
    PG8_WAIT_V(2); PG8_BAR;
    PG8_STAGE(PG8_SB(1, 0), cB + kstep, voffB); PG8_STAGE(PG8_SA(1, 0), cA + kstep, voffA); PG8_STAGE(PG8_SB(1, 1), cB + hsB + kstep, voffB);
    PG8_WAIT_V(6); PG8_BAR;
    for (;;) {
        const bool has_next = S.next(ui + 1, nxt);
        const char* nA = has_next ? (const char*)gA + (size_t)nxt.pm * tsA : cA; const char* nB = has_next ? (const char*)gBt + (size_t)nxt.pn * tsB : cB;
#pragma nounroll
        for (int t = 0; t < nt; t += 2) {
            const bool last = (t == nt - 2);
            const char* a1 = cA + (size_t)(t + 1) * kstep;
            const char* a2 = last ? nA : cA + (size_t)(t + 2) * kstep; const char* b2 = last ? nB : cB + (size_t)(t + 2) * kstep;
            const char* a3 = a2 + kstep; const char* b3 = b2 + kstep;
            PG8_LDB(B0, 0, 0); PG8_LDB(B1, 0, 1); PG8_SCHED; PG8_LDA(At, 0, 0); PG8_STAGE(PG8_SA(1, 1), a1 + hsA, voffA);
            PG8_WAIT_V(8); PG8_WAIT_L(0); PG8_BAR; PG8_MMA(0, 0, At, B0); PG8_MMA(0, 1, At, B1); PG8_BAR; PG8_SCHED;
            PG8_LDA(At, 0, 1); PG8_STAGE(PG8_SB(0, 0), b2, voffB); PG8_STAGE(PG8_SB(0, 1), b2 + hsB, voffB); PG8_STAGE(PG8_SA(0, 0), a2, voffA);
            PG8_WAIT_V(8); PG8_WAIT_L(0); PG8_BAR; PG8_MMA(1, 0, At, B0); PG8_MMA(1, 1, At, B1); PG8_BAR; PG8_SCHED;
            PG8_LDB(B0, 1, 0); PG8_LDB(B1, 1, 1); PG8_SCHED; PG8_LDA(At, 1, 0); PG8_STAGE(PG8_SA(0, 1), a2 + hsA, voffA);
            PG8_WAIT_V(8); PG8_WAIT_L(0); PG8_BAR; PG8_MMA(0, 0, At, B0); PG8_MMA(0, 1, At, B1); PG8_BAR; PG8_SCHED;
            PG8_LDA(At, 1, 1); PG8_STAGE(PG8_SB(1, 0), b3, voffB); PG8_STAGE(PG8_SB(1, 1), b3 + hsB, voffB); PG8_STAGE(PG8_SA(1, 0), a3, voffA);
            PG8_WAIT_V(8); PG8_WAIT_L(0); PG8_BAR; PG8_MMA(1, 0, At, B0); PG8_MMA(1, 1, At, B1); PG8_BAR; PG8_SCHED;
        }
        if (wr == 0) PG8_BAR;
        E(acc, cur, wr, wc, fr, fq);
        if (!has_next) break;
#pragma unroll
        for (int a = 0; a < 2; ++a)
#pragma unroll
            for (int b = 0; b < 2; ++b)
#pragma unroll
                for (int m = 0; m < 4; ++m)
#pragma unroll
                    for (int n = 0; n < 2; ++n) acc[a][b][m][n] = (f32x4){0.f, 0.f, 0.f, 0.f};
        cur = nxt; cA = nA; cB = nB; ++ui;
        if (wr == 1) PG8_BAR;
    }
    PG8_WAIT_V(0);
    PG8_BAR;
#undef PG8_SA
#undef PG8_SB
#undef PG8_STAGE
#undef PG8_LDA
#undef PG8_LDB
#undef PG8_MMA
#undef PG8_WAIT_V
#undef PG8_WAIT_L
#undef PG8_BAR
#undef PG8_SCHED
}
}

constexpr int NB = 16, SEQ = 2048, DM = 1024, MT = NB * SEQ, DFF = 2816;
constexpr float EPS = 1e-6f;
constexpr float LOG2E = 1.4426950408889634f;
constexpr size_t MiB = 1u << 20;
constexpr size_t WS_EVEN = 0, EVEN_STRIDE = 8 * MiB;
constexpr size_t WS_ODD = 16 * MiB, ODD_STRIDE = 8 * MiB;
constexpr size_t WS_FFN = 32 * MiB, FFN_STRIDE = 17 * MiB;
constexpr size_t WS_ROPE = 100 * MiB;
constexpr size_t WS_XB = 102 * MiB, WS_MIX = 166 * MiB, WS_R = 230 * MiB;
constexpr size_t WS_P = WS_R, WS_VTA = WS_R + 96 * MiB, WS_QB = WS_R + 128 * MiB, WS_VTB = WS_R + 208 * MiB;
constexpr size_t WS_QK = WS_R, WS_VTC = WS_R + 128 * MiB, WS_ACT = WS_R, WS_CTL = 470 * MiB, CTL_BYTES = 16384, WS_SS = 471 * MiB, WS_END = 473 * MiB;
constexpr int LDS_BYTES = 131072 + 128;
#ifndef ATT_REP
#define ATT_REP 1
#endif
#ifndef ATT_REP_O
#define ATT_REP_O 1
#endif
#ifndef GU_REP
#define GU_REP 1
#endif
#ifndef EW_REP
#define EW_REP 1
#endif
#ifndef SYNC_REP
#define SYNC_REP 1
#endif

struct Args { const float* in[22]; float* out; unsigned char* ws; };
typedef const __attribute__((address_space(4))) Args* KA;
__device__ __forceinline__ KA ka_get() { KA p = (KA)__builtin_amdgcn_kernarg_segment_ptr(); asm volatile("" : "+s"(p)); return p; }

__device__ __forceinline__ float wave_sum(float v) {
    v += SWZ_XOR(v, 1); v += SWZ_XOR(v, 2); v += SWZ_XOR(v, 4); v += SWZ_XOR(v, 8); v += SWZ_XOR(v, 16);
    return x32_sum(v);
}

struct PJ { const float* W; int K, ld, c0, ncols, grp, sgrp, dgrp; bf16_t* WT; int row_off; const float* gain; int ldd, kofs, mode; };
__device__ __forceinline__ PJ get_job(int j, KA a) {
    PJ p; unsigned char* ws = a->ws;
    p.grp = 1 << 20; p.sgrp = 0; p.dgrp = 0; p.c0 = 0; p.row_off = 0; p.gain = nullptr; p.ldd = 0; p.kofs = 0; p.mode = 0;
    if (j < 16) {
        const int i = j / 8, s = j % 8; unsigned char* wb = ws + WS_EVEN + i * EVEN_STRIDE; const float* win = a->in[3] + (size_t)i * 1024 * 1952; const float* gm = a->in[1] + (size_t)(2 * i) * 1024;
        if (s == 0) { p.W = win; p.K = 1024; p.ld = 1952; p.c0 = 0; p.ncols = 1024; p.WT = (bf16_t*)wb; p.row_off = 0; p.gain = gm; }
        else if (s == 1) { p.W = win; p.K = 1024; p.ld = 1952; p.c0 = 1024; p.ncols = 512; p.WT = (bf16_t*)(wb + 3 * MiB); p.gain = gm; }
        else if (s == 2) { p.W = win; p.K = 1024; p.ld = 1952; p.c0 = 1536; p.ncols = 416; p.WT = (bf16_t*)wb; p.row_off = 1024; p.gain = gm; }
        else if (s == 3) { p.W = a->in[9] + (size_t)i * 256 * 768; p.K = 256; p.ld = 768; p.ncols = 512; p.WT = (bf16_t*)(wb + 6 * MiB); p.ldd = 384; p.mode = 1; }
        else if (s == 7) { p.W = a->in[9] + (size_t)i * 256 * 768; p.K = 256; p.ld = 768; p.ncols = 256; p.WT = (bf16_t*)(wb + 6 * MiB); p.ldd = 384; p.mode = 2; }
        else if (s == 4) { p.W = a->in[11] + (size_t)i * 128 * 1024; p.K = 128; p.ld = 1024; p.c0 = 0; p.ncols = 512; p.WT = (bf16_t*)(wb + 6 * MiB); p.ldd = 384; p.kofs = 256; p.mode = 3; }
        else if (s == 5) { p.W = a->in[11] + (size_t)i * 128 * 1024; p.K = 128; p.ld = 1024; p.c0 = 64; p.ncols = 512; p.grp = 64; p.sgrp = 128; p.dgrp = 64; p.WT = (bf16_t*)(wb + 6 * MiB + 960 * 1024); p.ldd = 384; p.kofs = 256; }
        else { p.W = a->in[16] + (size_t)i * 1024 * 1024; p.K = 1024; p.ld = 1024; p.ncols = 1024; p.WT = (bf16_t*)(wb + 4 * MiB); }
    } else if (j < 22) {
        const int i = (j - 16) / 3, s = (j - 16) % 3; unsigned char* wb = ws + WS_ODD + i * ODD_STRIDE; const float* gm = a->in[1] + (size_t)(2 * i + 1) * 1024;
        if (s == 0) { p.W = a->in[17] + (size_t)i * 1024 * 3072; p.K = 1024; p.ld = 3072; p.c0 = 0; p.ncols = 2048; p.WT = (bf16_t*)wb; p.gain = gm; }
        else if (s == 1) { p.W = a->in[17] + (size_t)i * 1024 * 3072; p.K = 1024; p.ld = 3072; p.c0 = 2048; p.ncols = 1024; p.WT = (bf16_t*)(wb + 4 * MiB); p.gain = gm; }
        else { p.W = a->in[18] + (size_t)i * 1024 * 1024; p.K = 1024; p.ld = 1024; p.ncols = 1024; p.WT = (bf16_t*)(wb + 6 * MiB); }
    } else {
        const int l = (j - 22) / 3, s = (j - 22) % 3; unsigned char* wb = ws + WS_FFN + l * FFN_STRIDE; const float* gf = a->in[2] + (size_t)l * 1024;
        if (s == 0) { p.W = a->in[19] + (size_t)l * 1024 * DFF; p.K = 1024; p.ld = DFF; p.ncols = DFF; p.grp = 128; p.sgrp = 128; p.dgrp = 256; p.WT = (bf16_t*)wb; p.row_off = 0; p.gain = gf; }
        else if (s == 1) { p.W = a->in[20] + (size_t)l * 1024 * DFF; p.K = 1024; p.ld = DFF; p.ncols = DFF; p.grp = 128; p.sgrp = 128; p.dgrp = 256; p.WT = (bf16_t*)wb; p.row_off = 128; p.gain = gf; }
        else { p.W = a->in[21] + (size_t)l * DFF * 1024; p.K = DFF; p.ld = 1024; p.ncols = 1024; p.WT = (bf16_t*)(wb + 11 * MiB); }
    }
    return p;
}
constexpr int NJOBS = 34;

__device__ __forceinline__ void prep_phase(KA a, LAS unsigned char* lds, int NGW, int wv_s) {
    const int tid = launder_tid(), lane = tid & 63, wave = __builtin_amdgcn_readfirstlane(tid >> 6), gw = blockIdx.x * 8 + wave;
    LAS float* scr = (LAS float*)(lds + wave * 8448);
    int rot = 0;
    for (int j = 0; j < NJOBS; ++j) {
        PJ p = get_job(j, a); if (p.ldd == 0) p.ldd = p.K;
        const int nblk = p.ncols / 32, nitems = (p.K / 64) * nblk;
        int start = gw - rot; if (start < 0) start += NGW;
        for (int it = start; it < nitems; it += NGW) {
            const int kb = it / nblk, nb = it % nblk, k0 = 64 * kb, nn0 = 32 * nb;
            const int q = nn0 / p.grp, r = nn0 % p.grp;
            int sc = p.c0 + q * p.sgrp + r, dr = p.row_off + q * p.dgrp + r;
            if (p.mode == 1) { const int hh = nb >> 1, hf = nb & 1; sc = 96 * hh + 32 * hf; dr = 256 * (hh >> 2) + 128 * hf + 32 * (hh & 3); }
            else if (p.mode == 2) { sc = 96 * nb + 64; dr = 512 + 128 * (nb >> 2) + 32 * (nb & 3); }
            else if (p.mode == 3) { const int hh = nb >> 1, hf = nb & 1; sc = 128 * hh + 32 * hf; dr = 768 + 256 * (hh >> 2) + 128 * hf + 32 * (hh & 3); }
            f32x4 wv[8]; float gv[8];
            const int nq = (lane & 7) * 4;
#pragma unroll
            for (int i = 0; i < 8; ++i) { const int kk = 8 * i + (lane >> 3); wv[i] = __builtin_nontemporal_load((const f32x4*)(p.W + (size_t)(k0 + kk) * p.ld + sc + nq));       gv[i] = p.gain ? p.gain[k0 + kk] : 1.f; }
#pragma unroll
            for (int i = 0; i < 8; ++i) { const int kk = 8 * i + (lane >> 3); LAS float* d = scr + kk * 33 + nq;
                d[0] = wv[i].x * gv[i]; d[1] = wv[i].y * gv[i]; d[2] = wv[i].z * gv[i]; d[3] = wv[i].w * gv[i]; }
            asm volatile("s_waitcnt lgkmcnt(0)" ::: "memory");
            const int c = lane & 7;
#pragma unroll
            for (int jj = 0; jj < 4; ++jj) { const int n = (lane >> 3) + 8 * jj; const LAS float* s = scr + (8 * c) * 33 + n;
                u32x4 o; o.x = pk2(s[0 * 33], s[1 * 33]); o.y = pk2(s[2 * 33], s[3 * 33]); o.z = pk2(s[4 * 33], s[5 * 33]); o.w = pk2(s[6 * 33], s[7 * 33]);
                *(u32x4*)(p.WT + (size_t)(dr + n) * p.ldd + p.kofs + k0 + 8 * c) = o; }
            asm volatile("s_waitcnt lgkmcnt(0)" ::: "memory");
        }
        rot = (rot + nitems) % NGW;
    }
    float2* tab64 = (float2*)(a->ws + WS_ROPE); float2* tab32 = (float2*)(a->ws + WS_ROPE + 512 * 1024);
    const int gt = gw * 64 + lane, NT = NGW * 64;
    for (int e = gt; e < SEQ * 48; e += NT) {
        const int pos = e / 48, r = e % 48; const int half = r < 32 ? 32 : 16, i = r < 32 ? r : r - 32;
        const float inv = ex2(-((float)i / (float)half) * 13.287712379549449f);
        const float ang = (float)pos * inv;
        const float k = rintf(ang * 0.15915494309189535f);
        float rr = fmaf(-k, 6.2831854820251465f, ang); rr = fmaf(-k, -1.7484555e-07f, rr);
        const float2 cs = make_float2(__cosf(rr), __sinf(rr));
        if (r < 32) tab64[pos * 32 + i] = cs; else tab32[pos * 16 + i] = cs;
    }
}

__device__ __forceinline__ void norm_phase(const float* x, bf16_t* xb, float* ss, int NGW, int wv_s) {
    const int tid = launder_tid(), lane = tid & 63, gw = blockIdx.x * 8 + __builtin_amdgcn_readfirstlane(tid >> 6);
    for (int m0 = gw * 4; m0 < MT; m0 += NGW * 4) {
        f32x4 v[4][4];
#pragma unroll
        for (int r = 0; r < 4; ++r) { const f32x4* xr = (const f32x4*)(x + (size_t)(m0 + r) * DM) + lane;
#pragma unroll
            for (int j = 0; j < 4; ++j) v[r][j] = __builtin_nontemporal_load(xr + 64 * j); }
#pragma unroll
        for (int r = 0; r < 4; ++r) { const int m = m0 + r; float s = 0.f;
#pragma unroll
            for (int j = 0; j < 4; ++j) s += (v[r][j].x * v[r][j].x + v[r][j].y * v[r][j].y) + (v[r][j].z * v[r][j].z + v[r][j].w * v[r][j].w);
            const float tot = wave_sum(s);
            u32x2* o8 = (u32x2*)(xb + (size_t)m * DM) + lane;
#pragma unroll
            for (int j = 0; j < 4; ++j) { u32x2 w; w.x = pk2(v[r][j].x, v[r][j].y); w.y = pk2(v[r][j].z, v[r][j].w); o8[64 * j] = w; }
            if (lane < 16) ss[(size_t)m * 16 + lane] = (lane == 0) ? tot : 0.f; }
    }
}

__device__ __forceinline__ void unpack8(const u32x4 w, float (&f)[8]) { f[0] = bflo(w.x); f[1] = bfhi(w.x); f[2] = bflo(w.y); f[3] = bfhi(w.y); f[4] = bflo(w.z); f[5] = bfhi(w.z); f[6] = bflo(w.w); f[7] = bfhi(w.w); }
__device__ __forceinline__ u32x4 pack8(const float (&f)[8]) { u32x4 w; w.x = pk2(f[0], f[1]); w.y = pk2(f[2], f[3]); w.z = pk2(f[4], f[5]); w.w = pk2(f[6], f[7]); return w; }

constexpr int PNT = 4;
__device__ __forceinline__ void post_e2(KA a, int i, int NGW, int wv_s) {
    const int tid = launder_tid(), lane = tid & 63, gw = blockIdx.x * 8 + __builtin_amdgcn_readfirstlane(tid >> 6);
    bf16_t* P = (bf16_t*)(a->ws + WS_P);
    const float2* tab64 = (const float2*)(a->ws + WS_ROPE); const float2* tab32 = (const float2*)(a->ws + WS_ROPE + 512 * 1024);
    const float* gq = a->in[4] + i * 64; const float* gk = a->in[5] + i * 64;
    const float* gql = a->in[8] + i * 256; const float* gkv = a->in[10] + i * 128; const float* gkr = a->in[15] + i * 32;
    const int gI = lane >> 2, sub = lane & 3, e0 = sub * 8;
    const float* gn = (gI < 8) ? gq : gk;
    float g1[8], g2[8];
#pragma unroll
    for (int j = 0; j < 8; ++j) { g1[j] = gn[e0 + j]; g2[j] = gn[32 + e0 + j]; }
    const float qs = (gI < 8) ? 0.125f * LOG2E : 1.f;
    const f32x4 gql4 = *(const f32x4*)(gql + 4 * lane);
    const float gkv0 = gkv[2 * lane], gkv1 = gkv[2 * lane + 1];
    const int ii = lane & 15;
    const float gkr0 = gkr[ii], gkr1 = gkr[ii + 16];
    for (int m0 = gw * PNT; m0 < MT; m0 += NGW * PNT) {
        u32x4 A1[PNT], A2[PNT]; u32x2 Bq[PNT]; unsigned Ckv[PNT]; unsigned short D1[PNT], D2[PNT]; float2 T32[PNT];
#pragma unroll
        for (int t = 0; t < PNT; ++t) { bf16_t* row = P + (size_t)(m0 + t) * 1536; const int pos = (m0 + t) & (SEQ - 1);
            A1[t] = *(const u32x4*)(row + gI * 64 + e0); A2[t] = *(const u32x4*)(row + gI * 64 + e0 + 32);
            Bq[t] = *(const u32x2*)(row + 1024 + 4 * lane); Ckv[t] = *((const unsigned*)(row + 1280) + lane);
            D1[t] = row[1408 + ii]; D2[t] = row[1408 + 16 + ii]; T32[t] = tab32[pos * 16 + ii]; }
#pragma unroll
        for (int t = 0; t < PNT; ++t) {
            bf16_t* row = P + (size_t)(m0 + t) * 1536; const int pos = (m0 + t) & (SEQ - 1);
            {
                float x1[8], x2[8]; unpack8(A1[t], x1); unpack8(A2[t], x2);
                float ss = 0.f;
#pragma unroll
                for (int j = 0; j < 8; ++j) ss += x1[j] * x1[j] + x2[j] * x2[j];
                ss += SWZ_XOR(ss, 1); ss += SWZ_XOR(ss, 2);
                const float rstd = rsqrtf(ss * (1.f / 64.f) + EPS);
                float o1[8], o2[8];
                const f32x4* tp = (const f32x4*)(tab64 + pos * 32 + e0);
#pragma unroll
                for (int j2 = 0; j2 < 4; ++j2) { const f32x4 cs = tp[j2];
                    { const int j = 2 * j2; const float y1 = x1[j] * rstd * g1[j], y2 = x2[j] * rstd * g2[j]; o1[j] = (y1 * cs.x - y2 * cs.y) * qs; o2[j] = (y2 * cs.x + y1 * cs.y) * qs; }
                    { const int j = 2 * j2 + 1; const float y1 = x1[j] * rstd * g1[j], y2 = x2[j] * rstd * g2[j]; o1[j] = (y1 * cs.z - y2 * cs.w) * qs; o2[j] = (y2 * cs.z + y1 * cs.w) * qs; } }
                *(u32x4*)(row + gI * 64 + e0) = pack8(o1); *(u32x4*)(row + gI * 64 + e0 + 32) = pack8(o2);
            }
            {
                const u32x2 w = Bq[t];
                const float x0 = bflo(w.x), x1 = bfhi(w.x), x2 = bflo(w.y), x3 = bfhi(w.y);
                const float rstd = rsqrtf(wave_sum(x0 * x0 + x1 * x1 + x2 * x2 + x3 * x3) * (1.f / 256.f) + EPS);
                u32x2 o; o.x = pk2(x0 * rstd * gql4.x, x1 * rstd * gql4.y); o.y = pk2(x2 * rstd * gql4.z, x3 * rstd * gql4.w); *(u32x2*)(row + 1024 + 4 * lane) = o;
            }
            {
                const unsigned w = Ckv[t]; const float x0 = bflo(w), x1 = bfhi(w);
                const float rstd = rsqrtf(wave_sum(x0 * x0 + x1 * x1) * (1.f / 128.f) + EPS);
                *((unsigned*)(row + 1280) + lane) = pk2(x0 * rstd * gkv0, x1 * rstd * gkv1);
            }
            {
                const float x1 = __uint_as_float((unsigned)D1[t] << 16), x2 = __uint_as_float((unsigned)D2[t] << 16);
                float ss = x1 * x1 + x2 * x2;
                ss += SWZ_XOR(ss, 1); ss += SWZ_XOR(ss, 2); ss += SWZ_XOR(ss, 4); ss += SWZ_XOR(ss, 8);
                const float rstd = rsqrtf(ss * (1.f / 32.f) + EPS);
                const float2 cs = T32[t]; const float y1 = x1 * rstd * gkr0, y2 = x2 * rstd * gkr1;
                const unsigned r1 = pk2(y1 * cs.x - y2 * cs.y, 0.f), r2 = pk2(y2 * cs.x + y1 * cs.y, 0.f);
                if (lane < 16) { row[1408 + ii] = (bf16_t)(r1 & 0xffffu); row[1408 + 16 + ii] = (bf16_t)(r2 & 0xffffu); }
            }
        }
    }
}

__device__ __forceinline__ void post_e4(KA a, int i, int NGW, int wv_s) {
    const int tid = launder_tid(), lane = tid & 63, gw = blockIdx.x * 8 + __builtin_amdgcn_readfirstlane(tid >> 6);
    bf16_t* QB = (bf16_t*)(a->ws + WS_QB);
    const float2* tab32 = (const float2*)(a->ws + WS_ROPE + 512 * 1024);
    const float* gqn = a->in[12] + i * 64; const float* gqr = a->in[13] + i * 32; const float* gkn = a->in[14] + i * 64;
    const int h = lane >> 3, sub = lane & 7;
    float gq8[8], gk8[8];
#pragma unroll
    for (int j = 0; j < 8; ++j) { gq8[j] = gqn[sub * 8 + j]; gk8[j] = gkn[sub * 8 + j]; }
    const float gr0 = gqr[2 * sub], gr1 = gqr[2 * sub + 1], gr2 = gqr[16 + 2 * sub], gr3 = gqr[16 + 2 * sub + 1];
    const float CB = 0.10206207261596575f * LOG2E;
    for (int m0 = gw * PNT; m0 < MT; m0 += NGW * PNT) {
        u32x4 QN[PNT], KNv[PNT]; unsigned W1[PNT], W2[PNT]; f32x4 TC[PNT];
#pragma unroll
        for (int t = 0; t < PNT; ++t) { bf16_t* row = QB + (size_t)(m0 + t) * 1280; const int pos = (m0 + t) & (SEQ - 1);
            QN[t] = *(const u32x4*)(row + h * 96 + sub * 8); KNv[t] = *(const u32x4*)(row + 768 + h * 64 + sub * 8);
            const unsigned* p = (const unsigned*)(row + h * 96 + 64) + sub; W1[t] = p[0]; W2[t] = p[8];
            TC[t] = *(const f32x4*)(tab32 + pos * 16 + 2 * sub); }
#pragma unroll
        for (int t = 0; t < PNT; ++t) {
            bf16_t* row = QB + (size_t)(m0 + t) * 1280;
            {
                float x[8]; unpack8(QN[t], x);
                float ss = 0.f;
#pragma unroll
                for (int j = 0; j < 8; ++j) ss += x[j] * x[j];
                ss += SWZ_XOR(ss, 1); ss += SWZ_XOR(ss, 2); ss += SWZ_XOR(ss, 4);
                const float rstd = rsqrtf(ss * (1.f / 64.f) + EPS) * CB;
#pragma unroll
                for (int j = 0; j < 8; ++j) x[j] = x[j] * rstd * gq8[j];
                *(u32x4*)(row + h * 96 + sub * 8) = pack8(x);
            }
            {
                unsigned* p = (unsigned*)(row + h * 96 + 64) + sub; const unsigned w1 = W1[t], w2 = W2[t];
                const float a0 = bflo(w1), a1 = bfhi(w1), b0 = bflo(w2), b1 = bfhi(w2);
                float ss = a0 * a0 + a1 * a1 + b0 * b0 + b1 * b1;
                ss += SWZ_XOR(ss, 1); ss += SWZ_XOR(ss, 2); ss += SWZ_XOR(ss, 4);
                const float rstd = rsqrtf(ss * (1.f / 32.f) + EPS);
                const f32x4 c = TC[t];
                const float ya0 = a0 * rstd * gr0, ya1 = a1 * rstd * gr1, yb0 = b0 * rstd * gr2, yb1 = b1 * rstd * gr3;
                p[0] = pk2((ya0 * c.x - yb0 * c.y) * CB, (ya1 * c.z - yb1 * c.w) * CB);
                p[8] = pk2((yb0 * c.x + ya0 * c.y) * CB, (yb1 * c.z + ya1 * c.w) * CB);
            }
            {
                float x[8]; unpack8(KNv[t], x);
                float ss = 0.f;
#pragma unroll
                for (int j = 0; j < 8; ++j) ss += x[j] * x[j];
                ss += SWZ_XOR(ss, 1); ss += SWZ_XOR(ss, 2); ss += SWZ_XOR(ss, 4);
                const float rstd = rsqrtf(ss * (1.f / 64.f) + EPS);
#pragma unroll
                for (int j = 0; j < 8; ++j) x[j] = x[j] * rstd * gk8[j];
                *(u32x4*)(row + 768 + h * 64 + sub * 8) = pack8(x);
            }
        }
    }
}

template <int DK, int DV> struct AttnGeo {
    static constexpr int KS = DK * 2 + 16, KBYTES = 64 * KS, VS = 136, VBYTES = DV * VS;
    static constexpr int KOFF = 0, VOFF = 2 * KBYTES;
};
template <int DK> __device__ __forceinline__ int kchunk_off(int dc) { return 8 * dc; }
template <int DK, int DV>
__device__ __forceinline__ void stage_load(int tid, int j, const bf16_t* K1, int ldk1, const bf16_t* K2, int ldk2, const bf16_t* Vt, u32x4& kr0, u32x4& kr1, u32x4& vr0, u32x4& vr1) {
    constexpr int CPR = DK / 8;
    { const int c = tid, key = c / CPR, dc = c % CPR;
      const bf16_t* src = (DK == 64 || dc < 8) ? K1 + (size_t)(64 * j + key) * ldk1 + kchunk_off<DK>(dc) : K2 + (size_t)(64 * j + key) * ldk2 + (dc - 8) * 8;
      kr0 = *(const u32x4*)src; }
    if (DK == 96) { if (tid < 256) { const int c = tid + 512, key = c / CPR, dc = c % CPR;
      const bf16_t* src = (dc < 8) ? K1 + (size_t)(64 * j + key) * ldk1 + kchunk_off<DK>(dc) : K2 + (size_t)(64 * j + key) * ldk2 + (dc - 8) * 8;
      kr1 = *(const u32x4*)src; } }
    { const int c = tid, d = c >> 3, kc = c & 7; vr0 = *(const u32x4*)(Vt + (size_t)d * MT + 64 * j + kc * 8); }
    if (DV == 128) { const int c = tid + 512, d = c >> 3, kc = c & 7; vr1 = *(const u32x4*)(Vt + (size_t)d * MT + 64 * j + kc * 8); }
}
template <int DK, int DV>
__device__ __forceinline__ void stage_store(int tid, LAS unsigned char* Kb, LAS unsigned char* Vb, const u32x4& kr0, const u32x4& kr1, const u32x4& vr0, const u32x4& vr1) {
    typedef AttnGeo<DK, DV> G; constexpr int CPR = DK / 8;
    { const int c = tid, key = c / CPR, dc = c % CPR; *(LAS u32x4*)(Kb + key * G::KS + dc * 16) = kr0; }
    if (DK == 96) { if (tid < 256) { const int c = tid + 512, key = c / CPR, dc = c % CPR; *(LAS u32x4*)(Kb + key * G::KS + dc * 16) = kr1; } }
    { const int c = tid, d = c >> 3, kc = c & 7; LAS u32x2* p = (LAS u32x2*)(Vb + d * G::VS + kc * 16); p[0] = (u32x2){vr0.x, vr0.y}; p[1] = (u32x2){vr0.z, vr0.w}; }
    if (DV == 128) { const int c = tid + 512, d = c >> 3, kc = c & 7; LAS u32x2* p = (LAS u32x2*)(Vb + d * G::VS + kc * 16); p[0] = (u32x2){vr1.x, vr1.y}; p[1] = (u32x2){vr1.z, vr1.w}; }
}
template <int DK>
__device__ __forceinline__ void qk_tile(const LAS unsigned char* Kb, int KS, const bf16x8 (&Qf)[DK / 16], int r32, int hi, f32x16& S0, f32x16& S1, float init = 0.f) {
#pragma unroll
    for (int i = 0; i < 16; ++i) { S0[i] = init; S1[i] = init; }
#pragma unroll
    for (int kk = 0; kk < DK / 16; ++kk) {
        const bf16x8 a0 = *(const LAS bf16x8*)(Kb + r32 * KS + kk * 32 + hi * 16);
        const bf16x8 a1 = *(const LAS bf16x8*)(Kb + (32 + r32) * KS + kk * 32 + hi * 16);
        S0 = __builtin_amdgcn_mfma_f32_32x32x16_bf16(a0, Qf[kk], S0, 0, 0, 0);
        S1 = __builtin_amdgcn_mfma_f32_32x32x16_bf16(a1, Qf[kk], S1, 0, 0, 0);
    }
}
template <int DV>
__device__ __forceinline__ void pv_tile(const LAS unsigned char* Vb, const f32x16& P0, const f32x16& P1, int r32, int hi, f32x16 (&O)[DV / 32]) {
#pragma unroll
    for (int T = 0; T < 2; ++T)
#pragma unroll
        for (int jj = 0; jj < 2; ++jj) {
            const f32x16& Pt = T ? P1 : P0;
            u32x4 pw; pw.x = pk2(Pt[8 * jj + 0], Pt[8 * jj + 1]); pw.y = pk2(Pt[8 * jj + 2], Pt[8 * jj + 3]); pw.z = pk2(Pt[8 * jj + 4], Pt[8 * jj + 5]); pw.w = pk2(Pt[8 * jj + 6], Pt[8 * jj + 7]);
            const bf16x8 pb = __builtin_bit_cast(bf16x8, pw);
#pragma unroll
            for (int dd = 0; dd < DV / 32; ++dd) {
                const LAS unsigned char* vp = Vb + (32 * dd + r32) * 136 + (32 * T + 16 * jj + 4 * hi) * 2;
                const u32x2 lo = *(const LAS u32x2*)vp, h2 = *(const LAS u32x2*)(vp + 16);
                const u32x4 vw = {lo.x, lo.y, h2.x, h2.y};
                O[dd] = __builtin_amdgcn_mfma_f32_32x32x16_bf16(__builtin_bit_cast(bf16x8, vw), pb, O[dd], 0, 0, 0);
            }
        }
}

template <int DK, int DV, bool FIXED>
__device__ __forceinline__ void attn_sm_pass(LAS unsigned char* lds, int tid, int wave, int lane, const bf16_t* Qp, int ldq, const bf16_t* K1, int ldk1, const bf16_t* K2, int ldk2,
                                             const bf16_t* Vt, int u, float shift, int qrope_off, f32x16 (&O)[DV / 32], float& lsum) {
    typedef AttnGeo<DK, DV> G;
    const int r32 = lane & 31, hi = lane >> 5;
    bf16x8 Qf[DK / 16];
    { const bf16_t* qp = Qp + (size_t)(256 * u + 32 * wave + r32) * ldq + 8 * hi;
#pragma unroll
      for (int kk = 0; kk < DK / 16; ++kk) { const int off = 16 * kk; Qf[kk] = *(const bf16x8*)(qp + off); } }
#pragma unroll
    for (int dd = 0; dd < DV / 32; ++dd)
#pragma unroll
        for (int i = 0; i < 16; ++i) O[dd][i] = 0.f;
    float mrun = -INFINITY, l = 0.f;
    const int ntiles = 4 * u + 4, jw = 4 * u + (wave >> 1);
    u32x4 kr0, kr1, vr0, vr1;
    stage_load<DK, DV>(tid, 0, K1, ldk1, K2, ldk2, Vt, kr0, kr1, vr0, vr1);
    stage_store<DK, DV>(tid, lds + G::KOFF, lds + G::VOFF, kr0, kr1, vr0, vr1);
    __syncthreads();
    for (int j = 0; j < ntiles; ++j) {
        const int cb = j & 1;
        if (j + 1 < ntiles) stage_load<DK, DV>(tid, j + 1, K1, ldk1, K2, ldk2, Vt, kr0, kr1, vr0, vr1);
        if (j <= jw) {
            const LAS unsigned char* Kb = lds + G::KOFF + cb * G::KBYTES; const LAS unsigned char* Vb = lds + G::VOFF + cb * G::VBYTES;
            f32x16 S0, S1;
            if (FIXED) {
                qk_tile<DK>(Kb, G::KS, Qf, r32, hi, S0, S1, -shift);
                float ps = 0.f;
#pragma unroll
                for (int i = 0; i < 16; ++i) { S0[i] = ex2(S0[i]); S1[i] = ex2(S1[i]); ps += S0[i] + S1[i]; }
                l += ps;
            } else {
                qk_tile<DK>(Kb, G::KS, Qf, r32, hi, S0, S1);
                float mx = fmaxf(S0[0], S1[0]);
#pragma unroll
                for (int i = 1; i < 16; ++i) mx = fmaxf(mx, fmaxf(S0[i], S1[i]));
                mx = x32_max(mx);
                const float mnew = fmaxf(mrun, mx), alpha = ex2(mrun - mnew); mrun = mnew;
                float ps = 0.f;
#pragma unroll
                for (int i = 0; i < 16; ++i) { S0[i] = ex2(S0[i] - mnew); S1[i] = ex2(S1[i] - mnew); ps += S0[i] + S1[i]; }
                l = l * alpha + ps;
#pragma unroll
                for (int dd = 0; dd < DV / 32; ++dd) O[dd] = O[dd] * alpha;
            }
            pv_tile<DV>(Vb, S0, S1, r32, hi, O);
        }
        if (j + 1 < ntiles) stage_store<DK, DV>(tid, lds + G::KOFF + (cb ^ 1) * G::KBYTES, lds + G::VOFF + (cb ^ 1) * G::VBYTES, kr0, kr1, vr0, vr1);
        __syncthreads();
    }
    lsum = x32_sum(l);
}

__device__ __forceinline__ float wave_max(float v) {
    v = fmaxf(v, SWZ_XOR(v, 1)); v = fmaxf(v, SWZ_XOR(v, 2)); v = fmaxf(v, SWZ_XOR(v, 4)); v = fmaxf(v, SWZ_XOR(v, 8)); v = fmaxf(v, SWZ_XOR(v, 16));
    return x32_max(v);
}
__device__ __forceinline__ void store_o32(bf16_t* rowp  , const f32x16& v, int hi) {
#pragma unroll
    for (int gp = 0; gp < 2; ++gp) { const int g = 2 * gp;
        unsigned ax = pk2(v[4 * g], v[4 * g + 1]), ay = pk2(v[4 * g + 2], v[4 * g + 3]), bx = pk2(v[4 * g + 4], v[4 * g + 5]), by = pk2(v[4 * g + 6], v[4 * g + 7]);
        { auto r = __builtin_amdgcn_permlane32_swap(ax, bx, false, false); ax = r[0]; bx = r[1]; }
        { auto r = __builtin_amdgcn_permlane32_swap(ay, by, false, false); ay = r[0]; by = r[1]; }
        *(u32x4*)(rowp + 16 * gp + (hi ? 8 : 0)) = (u32x4){ax, ay, bx, by}; }
}
__device__ __forceinline__ void attn_a_unit(KA a, LAS unsigned char* lds, int i, int l, int b, int h, int u, int wv_s) {
    const int tid = launder_tid(), lane = tid & 63, wave = __builtin_amdgcn_readfirstlane(tid >> 6);
    const float bound = uni(8.f * LOG2E * 1.01f * wave_max(fabsf(a->in[4][i * 64 + lane])) * wave_max(fabsf(a->in[5][i * 64 + lane])));
    const bf16_t* P = (const bf16_t*)(a->ws + WS_P); const bf16_t* VtA = (const bf16_t*)(a->ws + WS_VTA); bf16_t* MIX = (bf16_t*)(a->ws + WS_MIX);
    const bf16_t* Pb = P + (size_t)b * SEQ * 1536; const bf16_t* Vt = VtA + (size_t)(h * 128) * MT + (size_t)b * SEQ;
    const float lam0 = 0.8f - 0.6f * expf(-0.3f * (float)l);
    f32x16 O[4], O1[4];
#pragma nounroll
    for (int half = 0; half < 2; ++half) {
        float ls;
        if (bound < 40.f) attn_sm_pass<64, 128, true>(lds, tid, wave, lane, Pb + h * 128 + half * 64, 1536, Pb + 512 + h * 128 + half * 64, 1536, nullptr, 0, Vt, u, bound, 0, O, ls);
        else attn_sm_pass<64, 128, false>(lds, tid, wave, lane, Pb + h * 128 + half * 64, 1536, Pb + 512 + h * 128 + half * 64, 1536, nullptr, 0, Vt, u, 0.f, 0, O, ls);
        if (half == 0) { const float r = 1.f / ls;
#pragma unroll
            for (int dd = 0; dd < 4; ++dd) O1[dd] = O[dd] * r; }
        else { const float* lf = a->in[6] + i * 256; const int ln = launder_tid() & 63;
            const float s1 = wave_sum(lf[ln] * lf[64 + ln]), s2 = wave_sum(lf[128 + ln] * lf[192 + ln]);
            const float lam = uni(expf(s1) - expf(s2) + lam0);
            const float r2 = lam / ls;
#pragma unroll
            for (int dd = 0; dd < 4; ++dd) O1[dd] = O1[dd] - O[dd] * r2; }
    }
    float ss = 0.f;
#pragma unroll
    for (int dd = 0; dd < 4; ++dd)
#pragma unroll
        for (int e = 0; e < 16; ++e) ss += O1[dd][e] * O1[dd][e];
    ss = x32_sum(ss);
    const float rstd = rsqrtf(ss * (1.f / 128.f) + EPS) * (1.f - lam0);
    const float* gout = a->in[7] + i * 128;
    const int lane2 = launder_tid() & 63, r32 = lane2 & 31, hi = lane2 >> 5;
    bf16_t* orow = MIX + (size_t)(b * SEQ + 256 * u + 32 * wave + r32) * 1024 + h * 128;
#pragma unroll
    for (int dd = 0; dd < 4; ++dd) {
#pragma unroll
        for (int g = 0; g < 4; ++g) { const f32x4 gv = *(const f32x4*)(gout + 32 * dd + 8 * g + 4 * hi);
            O1[dd][4 * g] *= rstd * gv.x; O1[dd][4 * g + 1] *= rstd * gv.y; O1[dd][4 * g + 2] *= rstd * gv.z; O1[dd][4 * g + 3] *= rstd * gv.w; }
        store_o32(orow + 32 * dd, O1[dd], hi); }
}
__device__ __forceinline__ void attn_b_unit(KA a, LAS unsigned char* lds, int i, int b, int h, int u, int wv_s) {
    const int tid = launder_tid(), lane = tid & 63, wave = __builtin_amdgcn_readfirstlane(tid >> 6);
    const float mqn = wave_max(fabsf(a->in[12][i * 64 + lane])), mkn = wave_max(fabsf(a->in[14][i * 64 + lane]));
    const float mqr = wave_max(fabsf(a->in[13][i * 32 + (lane & 31)])), mkr = wave_max(fabsf(a->in[15][i * 32 + (lane & 31)]));
    const float bound = (64.f * mqn * mkn + 32.f * mqr * mkr) * 0.10206207261596575f * LOG2E * 1.01f;
    const bf16_t* P = (const bf16_t*)(a->ws + WS_P); const bf16_t* QB = (const bf16_t*)(a->ws + WS_QB); const bf16_t* KN = QB + 768;
    const bf16_t* VtB = (const bf16_t*)(a->ws + WS_VTB); bf16_t* MIX = (bf16_t*)(a->ws + WS_MIX);
    f32x16 O[2]; float l;
    const int qrope_off = 0;
    if (bound < 40.f) attn_sm_pass<96, 64, true>(lds, tid, wave, lane, QB + (size_t)b * SEQ * 1280 + h * 96, 1280, KN + (size_t)b * SEQ * 1280 + h * 64, 1280, P + (size_t)b * SEQ * 1536 + 1408, 1536,
                         VtB + (size_t)(h * 64) * MT + (size_t)b * SEQ, u, bound, qrope_off, O, l);
    else attn_sm_pass<96, 64, false>(lds, tid, wave, lane, QB + (size_t)b * SEQ * 1280 + h * 96, 1280, KN + (size_t)b * SEQ * 1280 + h * 64, 1280, P + (size_t)b * SEQ * 1536 + 1408, 1536,
                         VtB + (size_t)(h * 64) * MT + (size_t)b * SEQ, u, 0.f, qrope_off, O, l);
    const float r = 1.f / l; const int r32 = lane & 31, hi = lane >> 5;
    bf16_t* orow = MIX + (size_t)(b * SEQ + 256 * u + 32 * wave + r32) * 1024 + 512 + h * 64;
#pragma unroll
    for (int dd = 0; dd < 2; ++dd) { O[dd] = O[dd] * r; store_o32(orow + 32 * dd, O[dd], hi); }
}
__device__ __forceinline__ void attn_c_unit(KA a, LAS unsigned char* lds, int b, int h, int u, int wv_s) {
    const int tid = launder_tid(), lane = tid & 63, wave = __builtin_amdgcn_readfirstlane(tid >> 6);
    typedef AttnGeo<64, 64> G;
    const bf16_t* QK = (const bf16_t*)(a->ws + WS_QK) + (size_t)b * SEQ * 2048; const bf16_t* K1 = QK + 1024 + h * 64;
    const bf16_t* Vt = (const bf16_t*)(a->ws + WS_VTC) + (size_t)(h * 64) * MT + (size_t)b * SEQ; bf16_t* MIX = (bf16_t*)(a->ws + WS_MIX);
    const int r32 = lane & 31, hi = lane >> 5;
    const int qpos = 256 * u + 32 * wave + r32;
    bf16x8 Qf[4];
    { const bf16_t* qp = QK + (size_t)qpos * 2048 + h * 64 + 8 * hi;
#pragma unroll
      for (int kk = 0; kk < 4; ++kk) Qf[kk] = *(const bf16x8*)(qp + 16 * kk); }
    f32x16 O[2];
#pragma unroll
    for (int dd = 0; dd < 2; ++dd)
#pragma unroll
        for (int e = 0; e < 16; ++e) O[dd][e] = 0.f;
    float trun = 1.f;
    const float STICK_TINY = 1e-37f;
    bool wdone = false;
    const int ntiles = 4 * u + 4, jw = 4 * u + (wave >> 1);
    u32x4 kr0, kr1, vr0, vr1;
    stage_load<64, 64>(tid, ntiles - 1, K1, 2048, nullptr, 0, Vt, kr0, kr1, vr0, vr1);
    stage_store<64, 64>(tid, lds + G::KOFF, lds + G::VOFF, kr0, kr1, vr0, vr1);
    __syncthreads();
    for (int idx = 0; idx < ntiles; ++idx) {
        const int j = ntiles - 1 - idx, cb = idx & 1;
        if (j > 0) stage_load<64, 64>(tid, j - 1, K1, 2048, nullptr, 0, Vt, kr0, kr1, vr0, vr1);
        if (j <= jw && !wdone) {
            const LAS unsigned char* Kb = lds + G::KOFF + cb * G::KBYTES; const LAS unsigned char* Vb = lds + G::VOFF + cb * G::VBYTES;
            f32x16 Z0, Z1;
            qk_tile<64>(Kb, G::KS, Qf, r32, hi, Z0, Z1);
            const bool diag = (j == jw); const int kbase = 64 * j + 4 * hi;
#pragma unroll
            for (int e = 0; e < 16; ++e) {
                const int key = kbase + 8 * (e >> 2) + (e & 3);
                float a0 = __builtin_amdgcn_rcpf(1.f + ex2(Z0[e])), a1 = __builtin_amdgcn_rcpf(1.f + ex2(Z1[e]));
                if (diag) { if (key >= qpos) a0 = 1.f; if (key + 32 >= qpos) a1 = 1.f; }
                Z0[e] = a0; Z1[e] = a1;
            }
            float seg[8], slo[8], sup[8];
#pragma unroll
            for (int g = 0; g < 4; ++g) { seg[g] = (Z0[4 * g] * Z0[4 * g + 1]) * (Z0[4 * g + 2] * Z0[4 * g + 3]); seg[4 + g] = (Z1[4 * g] * Z1[4 * g + 1]) * (Z1[4 * g + 2] * Z1[4 * g + 3]); }
#pragma unroll
            for (int s = 0; s < 8; ++s) { auto r = __builtin_amdgcn_permlane32_swap(__float_as_uint(seg[s]), __float_as_uint(seg[s]), false, false); slo[s] = __uint_as_float(r[0]); sup[s] = __uint_as_float(r[1]); }
            float run = trun;
#pragma unroll
            for (int s = 7; s >= 0; --s) {
                float f = (hi == 0) ? run * sup[s] : run;
                run *= slo[s] * sup[s];
                f32x16& Z = (s >= 4) ? Z1 : Z0; const int g = s & 3;
#pragma unroll
                for (int r = 3; r >= 0; --r) { const float fn = f * Z[4 * g + r]; Z[4 * g + r] = f - fn; f = fn; }
            }
            trun = run;
            pv_tile<64>(Vb, Z0, Z1, r32, hi, O);
            wdone = (__ballot(trun >= STICK_TINY) == 0ull);
        }
        if (j > 0) stage_store<64, 64>(tid, lds + G::KOFF + (cb ^ 1) * G::KBYTES, lds + G::VOFF + (cb ^ 1) * G::VBYTES, kr0, kr1, vr0, vr1);
        {
            volatile LAS unsigned* fl = (volatile LAS unsigned*)(lds + 131072 + 32 + (idx & 1) * 32);
            if (lane == 0) fl[wave] = wdone ? 1u : 0u;
            __syncthreads();
            const unsigned all = fl[0] & fl[1] & fl[2] & fl[3] & fl[4] & fl[5] & fl[6] & fl[7];
            if (all) break;
        }
    }
    bf16_t* orow = MIX + (size_t)(b * SEQ + qpos) * 1024 + h * 64;
#pragma unroll
    for (int dd = 0; dd < 2; ++dd) store_o32(orow + 32 * dd, O[dd], hi);
}


#define XB_TMO      128
#define XB_XCNT(j)  (256  + 64 * (j))
#define XB_XSUB(j)  (1280 + 64 * (j))
#define XB_XGEN(j)  (2304 + 64 * (j))
#define XB_TOP      3328
#define XB_TOPGEN   3392
#define XCD_BAR_WORDS 3456
#define XB_SPIN_CAP (1u << 18)
__device__ __forceinline__ unsigned xb_ld(unsigned* p)              { return __hip_atomic_load(p, __ATOMIC_RELAXED, __HIP_MEMORY_SCOPE_AGENT); }
__device__ __forceinline__ unsigned xb_add(unsigned* p, unsigned v) { return __hip_atomic_fetch_add(p, v, __ATOMIC_RELAXED, __HIP_MEMORY_SCOPE_AGENT); }
__device__ __forceinline__ unsigned xb_xcc_id() { return (unsigned)__builtin_amdgcn_s_getreg((3 << 11) | 20) & 0xFu; }
#define XB_SPIN(cond, bar) do { unsigned _sp = 0; while (cond) { __builtin_amdgcn_s_sleep(1); \
    if ((++_sp & 255u) == 0u) { if (xb_ld(&(bar)[XB_TMO])) break; if (_sp > XB_SPIN_CAP) { atomicAdd(&(bar)[XB_TMO], 1u); break; } } } } while (0)
struct XcdBarrier { unsigned* bar; unsigned x; volatile LAS unsigned* st; };
__device__ __forceinline__ XcdBarrier xcd_barrier_post(unsigned* bar, volatile LAS unsigned* st) {
    XcdBarrier b; b.bar = bar; b.x = xb_xcc_id(); b.st = st;
    if (threadIdx.x == 0) (void)xb_add(&bar[XB_XCNT(b.x)], 1u);
    return b;
}
__device__ __forceinline__ void xcd_barrier_complete(unsigned* bar, unsigned x, unsigned& nloc, unsigned& nx) {
    const unsigned G = gridDim.x * gridDim.y * gridDim.z;
    unsigned sum, cnt, mine, sp = 0u;
    for (;;) {
        sum = 0u; cnt = 0u; mine = 0u;
#pragma unroll
        for (unsigned j = 0; j < 16; ++j) { const unsigned c = xb_ld(&bar[XB_XCNT(j)]); sum += c; cnt += (c > 0u) ? 1u : 0u; mine = (j == x) ? c : mine; }
        if (sum == G) break;
        __builtin_amdgcn_s_sleep(1);
        if ((++sp & 255u) == 0u) { if (xb_ld(&bar[XB_TMO])) break; if (sp > XB_SPIN_CAP) { atomicAdd(&bar[XB_TMO], 1u); break; } }
    }
    nloc = mine > 0u ? mine : 1u; nx = cnt > 0u ? cnt : 1u;
}
__device__ __forceinline__ void xcd_barrier(const XcdBarrier& b, int tid) {
    asm volatile("s_waitcnt vmcnt(0)" ::: "memory");
    __syncthreads();
    if (tid == 0) {
        unsigned* bar = b.bar;
        __builtin_amdgcn_s_waitcnt(0);
        unsigned nloc = b.st[0], nx = b.st[1];
        if (nloc == 0u) { xcd_barrier_complete(bar, b.x, nloc, nx); b.st[0] = nloc; b.st[1] = nx; }
        const unsigned old = xb_add(&bar[XB_XSUB(b.x)], 1u);
        const unsigned gen = old / nloc;
        if (old + 1u == (gen + 1u) * nloc) {
            __builtin_amdgcn_fence(__ATOMIC_RELEASE, "agent");
            asm volatile("s_waitcnt vmcnt(0)" ::: "memory");
            const unsigned og = xb_add(&bar[XB_TOP], 1u);
            const unsigned tg = og / nx;
            if (og + 1u == (tg + 1u) * nx) xb_add(&bar[XB_TOPGEN], 1u);
            else XB_SPIN(xb_ld(&bar[XB_TOPGEN]) == tg, bar);
            __builtin_amdgcn_fence(__ATOMIC_ACQUIRE, "agent");
            xb_add(&bar[XB_XGEN(b.x)], 1u);
            asm volatile("s_waitcnt vmcnt(0)" ::: "memory");
        } else {
            XB_SPIN(xb_ld(&bar[XB_XGEN(b.x)]) == gen, bar);
            __builtin_amdgcn_fence(__ATOMIC_ACQUIRE, "agent");
            asm volatile("s_waitcnt vmcnt(0)" ::: "memory");
        }
    }
    __syncthreads();
}

__global__ void __launch_bounds__(512, 2) fwd_megakernel(Args a_unused) {
    extern __shared__ __attribute__((aligned(16))) unsigned char lds_raw[];
    LAS unsigned char* lds = (LAS unsigned char*)lds_raw;
    cg::grid_group grid = cg::this_grid();
    const int G = gridDim.x, bid = blockIdx.x, NGW = G * 8;
    const int wv_s = __builtin_amdgcn_readfirstlane(threadIdx.x >> 6);
    if (threadIdx.x < 32) ((LAS unsigned*)(lds + 131072))[threadIdx.x] = 0u;
    __syncthreads();
    if (blockIdx.x == 0) { unsigned* bw = (unsigned*)(ka_get()->ws + WS_CTL); for (int q = threadIdx.x; q < XCD_BAR_WORDS; q += 512) __hip_atomic_store(bw + q, 0u, __ATOMIC_RELAXED, __HIP_MEMORY_SCOPE_AGENT); }
#define GSYNC() do { XcdBarrier xb_; xb_.bar = (unsigned*)(ka_get()->ws + WS_CTL); xb_.x = xb_xcc_id(); xb_.st = (volatile LAS unsigned*)(lds + 131072); xcd_barrier(xb_, launder_tid()); } while (0)
#define WSP (ka_get()->ws)
#define OUTP (ka_get()->out)

    prep_phase(ka_get(), lds, NGW, wv_s);
    { KA a = ka_get(); norm_phase(a->in[0], (bf16_t*)(a->ws + WS_XB), (float*)(a->ws + WS_SS), NGW, wv_s); }
    grid.sync();
    (void)xcd_barrier_post((unsigned*)(ka_get()->ws + WS_CTL), (volatile LAS unsigned*)(lds + 131072));

    for (int l = 0; l < 4; ++l) {
        const int i = l >> 1;
        {
            const bool odd = (l & 1);
            for (int jb = 0; jb < 2; ++jb) {
                unsigned char* ws = WSP; const bf16_t* XB = (const bf16_t*)(ws + WS_XB);
                unsigned char* wb = odd ? ws + WS_ODD + i * ODD_STRIDE : ws + WS_EVEN + i * EVEN_STRIDE;
                const bf16_t *A, *Bt; int Mg, Ng; pg8::EpiStore E; pg8::StaticOrder S;
                if (jb == 0) { A = XB; Bt = (const bf16_t*)wb; Mg = MT; Ng = odd ? 2048 : 1536; E = pg8::EpiStore{(bf16_t*)(ws + WS_R), Ng, odd ? 0.125f * LOG2E : 1.f, odd ? 4 : 0, (const float*)(ws + WS_SS), 1}; }
                else { A = (const bf16_t*)(wb + (odd ? 4 : 3) * MiB); Bt = XB; Mg = odd ? 1024 : 512; Ng = MT; E = pg8::EpiStore{(bf16_t*)(ws + (odd ? WS_VTC : WS_VTA)), MT, 1.f, 0, (const float*)(ws + WS_SS), 2}; }
                S.init(Mg, Ng, G, bid);
                pg8::gemm_phase<pg8::EpiStore, 1024, 1024, 1024>(lds, A, Bt, S, E, wv_s);
            }
        }
        GSYNC();
        if ((l & 1) == 0) {
            post_e2(ka_get(), i, NGW, wv_s);
            GSYNC();
            {
                { unsigned char* ws = WSP; unsigned char* wb = ws + WS_EVEN + i * EVEN_STRIDE; const bf16_t* P = (const bf16_t*)(ws + WS_P);
                  KA a = ka_get();
                  pg8::EpiLatent E{(bf16_t*)(ws + WS_QB), a->in[12] + i * 64, a->in[13] + i * 32, a->in[14] + i * 64, (const float2*)(ws + WS_ROPE + 512 * 1024), 0.10206207261596575f * LOG2E, 0}; pg8::StaticOrder S; S.init(MT, 768, G, bid);
                  pg8::gemm_phase<pg8::EpiLatent, 256, 1536, 384>(lds, P + 1024, (const bf16_t*)(wb + 6 * MiB), S, E, wv_s); }
                { unsigned char* ws = WSP; unsigned char* wb = ws + WS_EVEN + i * EVEN_STRIDE; const bf16_t* P = (const bf16_t*)(ws + WS_P);
                  KA a = ka_get();
                  pg8::EpiLatent E{(bf16_t*)(ws + WS_QB), a->in[12] + i * 64, a->in[13] + i * 32, a->in[14] + i * 64, (const float2*)(ws + WS_ROPE + 512 * 1024), 0.10206207261596575f * LOG2E, 3}; pg8::StaticOrder S; S.init(MT, 512, G, bid);
                  pg8::gemm_phase<pg8::EpiLatent, 128, 1536, 384>(lds, P + 1280, (const bf16_t*)(wb + 6 * MiB) + 768 * 384 + 256, S, E, wv_s); }
                { unsigned char* ws = WSP; unsigned char* wb = ws + WS_EVEN + i * EVEN_STRIDE; const bf16_t* P = (const bf16_t*)(ws + WS_P);
                  pg8::EpiStore E{(bf16_t*)(ws + WS_VTB), MT, 1.f, 0, nullptr, 0}; pg8::StaticOrder S; S.init(512, MT, G, bid);
                  pg8::gemm_phase<pg8::EpiStore, 128, 384, 1536>(lds, (const bf16_t*)(wb + 6 * MiB + 960 * 1024) + 256, P + 1280, S, E, wv_s); }
            }
            GSYNC();
            {
                const int vb = (G % 8 == 0) ? (bid & 7) * (G >> 3) + (bid >> 3) : bid;
                for (int rep = 0; rep < ATT_REP; ++rep)
                for (int it = vb; it < 768; it += G) {
                    if (it < 256) { const int b = it >> 4, h = (it >> 2) & 3, up = it & 3;
                        for (int k = 0; k < 2; ++k) attn_a_unit(ka_get(), lds, i, l, b, h, k ? up : 7 - up, wv_s); }
                    else { const int p = it - 256, b = p >> 5, h = (p >> 2) & 7, up = p & 3;
                        for (int k = 0; k < 2; ++k) attn_b_unit(ka_get(), lds, i, b, h, k ? up : 7 - up, wv_s); }
                }
            }
        } else {
            const int vb = (G % 8 == 0) ? (bid & 7) * (G >> 3) + (bid >> 3) : bid;
            for (int rep = 0; rep < ATT_REP_O; ++rep)
            for (int it = vb; it < 1024; it += G) { const int b = it >> 6, h = (it >> 2) & 15, up = it & 3;
                for (int k = 0; k < 2; ++k) attn_c_unit(ka_get(), lds, b, h, k ? up : 7 - up, wv_s); }
        }
        GSYNC();
        {
            unsigned char* ws = WSP;
            const bf16_t* Wo = (l & 1) ? (const bf16_t*)(ws + WS_ODD + i * ODD_STRIDE + 6 * MiB) : (const bf16_t*)(ws + WS_EVEN + i * EVEN_STRIDE + 4 * MiB);
            pg8::EpiResid E{nullptr, 1024, (bf16_t*)(ws + WS_XB), (float*)(ws + WS_SS)}; pg8::StaticOrder S; S.init(MT, 1024, G, bid);
            pg8::gemm_phase<pg8::EpiResid, 1024, 1024, 1024>(lds, (const bf16_t*)(ws + WS_MIX), Wo, S, E, wv_s);
        }
        GSYNC();
        for (int rep = 0; rep < GU_REP; ++rep)
        { unsigned char* ws = WSP; unsigned char* wf = ws + WS_FFN + l * FFN_STRIDE;
          pg8::EpiSwiglu E{(bf16_t*)(ws + WS_ACT), DFF, (const float*)(ws + WS_SS)}; pg8::StaticOrder S; S.init(MT, 2 * DFF, G, bid);
          pg8::gemm_phase<pg8::EpiSwiglu, 1024, 1024, 1024>(lds, (const bf16_t*)(ws + WS_XB), (const bf16_t*)wf, S, E, wv_s); }
        GSYNC();
        { KA a = ka_get(); unsigned char* ws = a->ws; float* out = a->out; unsigned char* wf = ws + WS_FFN + l * FFN_STRIDE;
          pg8::EpiResid E{(l == 3) ? out : nullptr, 1024, (bf16_t*)(ws + WS_XB), (float*)(ws + WS_SS)}; pg8::StaticOrder S; S.init(MT, 1024, G, bid);
          pg8::gemm_phase<pg8::EpiResid, DFF, DFF, DFF>(lds, (const bf16_t*)(ws + WS_ACT), (const bf16_t*)(wf + 11 * MiB), S, E, wv_s); }
        GSYNC();
    }
}

extern "C" void kernel_launch(void* const* d_in, const int* in_sizes, int n_in, void* d_out, int out_size, void* d_ws, size_t ws_size, hipStream_t stream) {
    static int grid = 0;
    if (grid == 0) {
        if (n_in != 22 || ws_size < WS_END) { fprintf(stderr, "kernel_launch: unexpected n_in %d or ws_size %zu\n", n_in, ws_size); grid = -1; return; }
        int dev = 0, cus = 0, per_cu = 0;
        hipGetDevice(&dev);
        hipDeviceGetAttribute(&cus, hipDeviceAttributeMultiprocessorCount, dev);
        if (hipFuncSetAttribute((const void*)fwd_megakernel, hipFuncAttributeMaxDynamicSharedMemorySize, LDS_BYTES) != hipSuccess) { fprintf(stderr, "kernel_launch: hipFuncSetAttribute failed\n"); grid = -1; return; }
        hipOccupancyMaxActiveBlocksPerMultiprocessor(&per_cu, (const void*)fwd_megakernel, 512, LDS_BYTES);
        if (per_cu < 1) per_cu = 1;
        (void)hipGetLastError();
        grid = cus * per_cu;
    }
    if (grid < 0) return;
    Args a{};
    for (int i = 0; i < 22; ++i) a.in[i] = (const float*)d_in[i];
    a.out = (float*)d_out; a.ws = (unsigned char*)d_ws;
    void* args[] = {&a};
    hipError_t e = hipLaunchCooperativeKernel((const void*)fwd_megakernel, dim3(grid), dim3(512), args, LDS_BYTES, stream);
    if (e != hipSuccess) fprintf(stderr, "cooperative launch failed: %s (grid %d)\n", hipGetErrorString(e), grid);
}
```
